# Optimizing an MI355X kernel written in HIP

```python
import math
import jax, jax.numpy as jnp
from jax import lax
import numpy as np

D_MODEL = 4096
BATCH = 1
SEQ = 8192
DEPTH = 1

D_MIX = D_MODEL
POOL_WIDTH = D_MIX // 4
POOL_WINDOWS = (2, 4, 8, 16)
POOL_GROUP = POOL_WIDTH // len(POOL_WINDOWS)
HEAD_DIM = 128
NSA_HEADS = (D_MIX - POOL_WIDTH) // HEAD_DIM
KV_GROUPS = 4
HEADS_PER_GROUP = NSA_HEADS // KV_GROUPS
KV_WIDTH = KV_GROUPS * HEAD_DIM
CMP_BLOCK = 32
CMP_STRIDE = 16
SLC_BLOCK = 64
N_SELECT = 16
N_LOCAL_FORCED = 2
WINDOW = 512
N_BRANCH = 3
Q_BLOCK = 128
REL_BUCKETS = 32
REL_MAX_DIST = 128
D_FF = 11008
CONV_WIDTH = 3
RMS_EPS = 1e-6
NEG = -1e30
N_IN = POOL_WIDTH + NSA_HEADS * HEAD_DIM + 6 * KV_WIDTH + NSA_HEADS * N_BRANCH

kernel_name = "hybrid_pool_nsa_convffn"


def _in_splits():
    sizes = [POOL_WIDTH, NSA_HEADS * HEAD_DIM] + [KV_WIDTH] * 6
    out, acc = [], 0
    for s in sizes:
        acc += s
        out.append(acc)
    return out


def _slc_overlap_weights():
    r = SLC_BLOCK // CMP_STRIDE
    lead = -(-CMP_BLOCK // CMP_STRIDE) - 1
    out = []
    for o in range(-lead, r):
        s0 = o * CMP_STRIDE
        ov = max(0, min(s0 + CMP_BLOCK, SLC_BLOCK) - max(s0, 0))
        if ov > 0:
            out.append((o, ov / CMP_STRIDE))
    return lead, out


def rms_norm(x, g):
    xf = x.astype(jnp.float32)
    y = xf * lax.rsqrt(jnp.mean(xf * xf, axis=-1, keepdims=True) + RMS_EPS)
    return (y * g.astype(jnp.float32)).astype(x.dtype)


def rel_bucket(dist):
    n = jnp.maximum(dist, 0)
    max_exact = REL_BUCKETS // 2
    nf = jnp.maximum(n, 1).astype(jnp.float32)
    large = max_exact + (jnp.log(nf / max_exact) / math.log(REL_MAX_DIST / max_exact)
                         * (REL_BUCKETS - max_exact)).astype(jnp.int32)
    large = jnp.minimum(large, REL_BUCKETS - 1)
    return jnp.where(n < max_exact, n, large)


def masked_softmax(s, valid):
    p = jax.nn.softmax(jnp.where(valid, s, NEG), axis=-1)
    return jnp.where(valid, p, 0.0)


def multiscale_pool(u, pool_w, pool_scale):
    B, S, _ = u.shape
    ug = u.astype(jnp.float32).reshape(B, S, len(POOL_WINDOWS), POOL_GROUP)
    c = jnp.cumsum(ug, axis=1)
    c = jnp.concatenate([jnp.zeros_like(c[:, :1]), c], axis=1)
    t = jnp.arange(S)
    outs = []
    for gi, w in enumerate(POOL_WINDOWS):
        lo = jnp.maximum(t + 1 - w, 0)
        cnt = (t + 1 - lo).astype(jnp.float32)
        mean = (c[:, 1:, gi] - c[:, lo, gi]) / cnt[None, :, None]
        outs.append(mean - ug[:, :, gi])
    d = jnp.stack(outs, axis=2).astype(u.dtype)
    y = jnp.einsum('bsgc,gce->bsge', d, pool_w)
    return y.reshape(B, S, POOL_WIDTH) * pool_scale


def compress(kv, pe, w1, w2):
    B, S, G, Dh = kv.shape
    r = CMP_BLOCK // CMP_STRIDE
    ch = kv.reshape(B, S // CMP_STRIDE, CMP_STRIDE, G, Dh)
    nc = S // CMP_STRIDE - r + 1
    blocks = jnp.concatenate([ch[:, j:j + nc] for j in range(r)], axis=2)
    blocks = blocks + pe[None, None, :, None, :]
    h = jax.nn.silu(jnp.einsum('bnlgd,lde->bnge', blocks, w1))
    return jnp.einsum('bnge,ef->bngf', h, w2)


def native_sparse_attention(q, k_cmp, v_cmp, k_slc, v_slc, k_win, v_win, gate_logits,
                            pe_k, w1_k, w2_k, pe_v, w1_v, w2_v, rel_bias):
    B, S, H, Dh = q.shape
    G, HPG = KV_GROUPS, HEADS_PER_GROUP
    dt = q.dtype
    kc = compress(k_cmp, pe_k, w1_k, w2_k)
    vc = compress(v_cmp, pe_v, w1_v, w2_v)
    NC = kc.shape[1]
    NS = S // SLC_BLOCK
    n_sel = min(N_SELECT, NS)
    r = SLC_BLOCK // CMP_STRIDE
    lead, slc_w = _slc_overlap_weights()
    right = r * NS + lead - (NC + lead)
    ks_t = k_slc.reshape(B, NS, SLC_BLOCK, G, Dh).transpose(0, 3, 1, 2, 4)
    vs_t = v_slc.reshape(B, NS, SLC_BLOCK, G, Dh).transpose(0, 3, 1, 2, 4)
    kw_pad = jnp.pad(k_win, ((0, 0), (WINDOW, 0), (0, 0), (0, 0)))
    vw_pad = jnp.pad(v_win, ((0, 0), (WINDOW, 0), (0, 0), (0, 0)))
    gates = jax.nn.sigmoid(gate_logits.astype(jnp.float32)).astype(dt)
    gates = gates.reshape(B, S, G, HPG, N_BRANCH)
    tbl = rel_bias.astype(jnp.float32).T.reshape(G, HPG, REL_BUCKETS)
    scale = HEAD_DIM ** -0.5
    nq = S // Q_BLOCK
    cmp_end = jnp.arange(NC) * CMP_STRIDE + CMP_BLOCK - 1
    jj = jnp.arange(NS)
    bi = jnp.arange(B)[:, None, None, None]
    gi = jnp.arange(G)[None, :, None, None]
    g6 = jnp.arange(G)[None, :, None, None, None, None]
    h6 = jnp.arange(HPG)[None, None, :, None, None, None]

    def block(args):
        i, qb, gb = args
        t = i * Q_BLOCK + jnp.arange(Q_BLOCK)
        qs = qb * scale
        dist_c = t[:, None] - cmp_end[None, :]
        s_c = jnp.einsum('bqghd,bngd->bghqn', qs, kc).astype(jnp.float32)
        s_c = s_c + tbl[:, :, rel_bucket(dist_c)]
        p_c = masked_softmax(s_c, dist_c >= 0)
        o_cmp = jnp.einsum('bghqn,bngd->bqghd', p_c.astype(dt), vc)
        imp = jnp.pad(p_c.sum(axis=2), ((0, 0), (0, 0), (0, 0), (lead, right)))
        slc = sum(w * lax.slice_in_dim(imp, o + lead, o + lead + r * (NS - 1) + 1, r, axis=-1)
                  for o, w in slc_w)
        cur = (t // SLC_BLOCK)[:, None]
        future = (jj[None, :] * SLC_BLOCK) > t[:, None]
        forced = (jj[None, :] == 0) | ((cur - jj[None, :] >= 0) & (cur - jj[None, :] < N_LOCAL_FORCED))
        score = jnp.where(forced, 1e9, jnp.where(future, -1e9, slc))
        _, idx = lax.top_k(score, n_sel)
        kg = ks_t[bi, gi, idx]
        vg = vs_t[bi, gi, idx]
        pos = idx[..., None] * SLC_BLOCK + jnp.arange(SLC_BLOCK)
        dist_s = t[None, None, :, None, None] - pos
        bias_s = tbl[g6, h6, rel_bucket(dist_s)[:, :, None]]
        s_s = jnp.einsum('bqghd,bgqkld->bghqkl', qs, kg).astype(jnp.float32) + bias_s
        s_s = jnp.where((dist_s >= 0)[:, :, None], s_s, NEG)
        shp = s_s.shape
        p_s = jax.nn.softmax(s_s.reshape(shp[:4] + (n_sel * SLC_BLOCK,)), axis=-1).reshape(shp)
        o_slc = jnp.einsum('bghqkl,bgqkld->bqghd', p_s.astype(dt), vg)
        kw = lax.dynamic_slice_in_dim(kw_pad, i * Q_BLOCK, Q_BLOCK + WINDOW, axis=1)
        vw = lax.dynamic_slice_in_dim(vw_pad, i * Q_BLOCK, Q_BLOCK + WINDOW, axis=1)
        kpos = i * Q_BLOCK - WINDOW + jnp.arange(Q_BLOCK + WINDOW)
        dist_w = t[:, None] - kpos[None, :]
        valid_w = (dist_w >= 0) & (dist_w < WINDOW) & (kpos[None, :] >= 0)
        s_w = jnp.einsum('bqghd,bkgd->bghqk', qs, kw).astype(jnp.float32)
        s_w = s_w + tbl[:, :, rel_bucket(dist_w)]
        p_w = masked_softmax(s_w, valid_w)
        o_win = jnp.einsum('bghqk,bkgd->bqghd', p_w.astype(dt), vw)
        o = gb[..., 0:1] * o_cmp + gb[..., 1:2] * o_slc + gb[..., 2:3] * o_win
        return o.reshape(B, Q_BLOCK, H * Dh)

    q_blocks = q.reshape(B, nq, Q_BLOCK, G, HPG, Dh).transpose(1, 0, 2, 3, 4, 5)
    g_blocks = gates.reshape(B, nq, Q_BLOCK, G, HPG, N_BRANCH).transpose(1, 0, 2, 3, 4, 5)
    out = lax.map(block, (jnp.arange(nq, dtype=jnp.int32), q_blocks, g_blocks))
    return out.transpose(1, 0, 2, 3).reshape(B, S, H * Dh)


def conv_ffn(h, w_up, conv_w, conv_b, w_down):
    S = h.shape[1]
    u = h @ w_up
    up = jnp.pad(u, ((0, 0), (CONV_WIDTH - 1, 0), (0, 0)))
    c = conv_b + sum(conv_w[k] * up[:, k:k + S] for k in range(CONV_WIDTH))
    a, b = jnp.split(c, 2, axis=-1)
    return (jax.nn.silu(a) * b) @ w_down


def setup_inputs(seed: int = 0) -> dict:
    key = jax.random.key(seed)
    ks = jax.random.split(key, 20)
    f = jnp.float32

    def nrm(k, shape, s):
        return jax.random.normal(k, shape, f) * s

    L = DEPTH
    return {
        "x": nrm(ks[0], (BATCH, SEQ, D_MODEL), 1.0),
        "norm_mix_g": 1.0 + nrm(ks[1], (L, D_MODEL), 0.02),
        "w_in": nrm(ks[2], (L, D_MODEL, N_IN), D_MODEL ** -0.5),
        "pool_w": nrm(ks[3], (L, len(POOL_WINDOWS), POOL_GROUP, POOL_GROUP), POOL_GROUP ** -0.5),
        "pool_scale": 1.0 + nrm(ks[4], (L, POOL_WIDTH), 0.02),
        "cmp_pe_k": nrm(ks[5], (L, CMP_BLOCK, HEAD_DIM), 0.02),
        "cmp_w1_k": nrm(ks[6], (L, CMP_BLOCK, HEAD_DIM, HEAD_DIM), (CMP_BLOCK * HEAD_DIM) ** -0.5),
        "cmp_w2_k": nrm(ks[7], (L, HEAD_DIM, HEAD_DIM), HEAD_DIM ** -0.5),
        "cmp_pe_v": nrm(ks[8], (L, CMP_BLOCK, HEAD_DIM), 0.02),
        "cmp_w1_v": nrm(ks[9], (L, CMP_BLOCK, HEAD_DIM, HEAD_DIM), (CMP_BLOCK * HEAD_DIM) ** -0.5),
        "cmp_w2_v": nrm(ks[10], (L, HEAD_DIM, HEAD_DIM), HEAD_DIM ** -0.5),
        "rel_bias": nrm(ks[11], (REL_BUCKETS, NSA_HEADS), 0.5),
        "w_out": nrm(ks[12], (L, D_MIX, D_MODEL), D_MIX ** -0.5),
        "norm_ffn_g": 1.0 + nrm(ks[13], (L, D_MODEL), 0.02),
        "w_up": nrm(ks[14], (L, D_MODEL, 2 * D_FF), D_MODEL ** -0.5),
        "conv_w": nrm(ks[15], (L, CONV_WIDTH, 2 * D_FF), CONV_WIDTH ** -0.5),
        "conv_b": nrm(ks[16], (L, 2 * D_FF), 0.02),
        "w_down": nrm(ks[17], (L, D_FF, D_MODEL), D_FF ** -0.5),
        "norm_final_g": 1.0 + nrm(ks[18], (D_MODEL,), 0.02),
    }


def reference(x, norm_mix_g, w_in, pool_w, pool_scale, cmp_pe_k, cmp_w1_k, cmp_w2_k,
              cmp_pe_v, cmp_w1_v, cmp_w2_v, rel_bias, w_out, norm_ffn_g, w_up, conv_w,
              conv_b, w_down, norm_final_g):
    B, S, _ = x.shape
    splits = _in_splits()
    h = x
    for l in range(DEPTH):
        hn = rms_norm(h, norm_mix_g[l])
        proj = hn @ w_in[l]
        u_pool, q, kc, vc, ksl, vsl, kw, vw, gl = jnp.split(proj, splits, axis=-1)
        kvs = lambda t: t.reshape(B, S, KV_GROUPS, HEAD_DIM)
        y_pool = multiscale_pool(u_pool, pool_w[l], pool_scale[l])
        y_nsa = native_sparse_attention(
            q.reshape(B, S, NSA_HEADS, HEAD_DIM), kvs(kc), kvs(vc), kvs(ksl), kvs(vsl),
            kvs(kw), kvs(vw), gl, cmp_pe_k[l], cmp_w1_k[l], cmp_w2_k[l],
            cmp_pe_v[l], cmp_w1_v[l], cmp_w2_v[l], rel_bias)
        h = h + jnp.concatenate([y_nsa, y_pool], axis=-1) @ w_out[l]
        h = h + conv_ffn(rms_norm(h, norm_ffn_g[l]), w_up[l], conv_w[l], conv_b[l], w_down[l])
    return rms_norm(h, norm_final_g)
```

```cpp
#include <hip/hip_runtime.h>
#include <hip/hip_cooperative_groups.h>
#include <cstdio>
#include <cstdint>
namespace cg = cooperative_groups;
namespace pg8 {
#define PG8_LAS __attribute__((address_space(3)))
typedef unsigned short bf16_t;
typedef short bf16x8 __attribute__((ext_vector_type(8)));
typedef float f32x4 __attribute__((ext_vector_type(4)));
typedef unsigned u32x4 __attribute__((ext_vector_type(4)));
constexpr int BM = 256, BK = 64, HALF = 128, HTB = HALF * BK * 2  , STAGE_BYTES = 8 * HTB, NXCD = 8, WGM = 8;

__host__ __device__ __forceinline__ int lds_byte(int r, int c) { const int st = (r >> 4) * 2 + (c >> 5), rr = r & 15, cc = c & 31, ob = rr * 64 + cc * 2; return st * 1024 + (ob ^ (((ob >> 9) & 1) << 5)); }
__host__ __device__ __forceinline__ void stage_rc(int b, int& R, int& C) { const int st = b / 1024, sb = b % 1024, swz = sb ^ (((sb >> 9) & 1) << 5); R = (st >> 1) * 16 + swz / 64; C = (st & 1) * 32 + (swz % 64) / 2; }
__host__ __device__ __forceinline__ int perm32(int rho) { const int n = rho >> 4, i = rho & 15; return 8 * (i >> 2) + 4 * n + (i & 3); }

struct Unit { int pm, pn; };
struct Gemm { const bf16_t* A; const bf16_t* Bt; int M, N, K; };

struct StaticOrder {
    int nM, nN, nwg, G, c;
    __host__ __device__ void init(int M, int N, int G_, int c_) { nM = M / BM; nN = N / BM; nwg = nM * nN; G = G_; c = c_; }
    __host__ __device__ bool next(int i, Unit& u) const {
        const long L = (long)i * G + c; if (L >= nwg) return false;
        int wgid = (int)L; { const int q = nwg / NXCD, r = nwg % NXCD, xcd = wgid % NXCD, off = wgid / NXCD; wgid = (xcd < r ? xcd * (q + 1) : r * (q + 1) + (xcd - r) * q) + off; }
        const int nig = WGM * nN, gid = wgid / nig, fm = gid * WGM, gsz = (nM - fm) < WGM ? (nM - fm) : WGM;
        u.pm = fm + ((wgid % nig) % gsz); u.pn = (wgid % nig) / gsz; return true;
    }
    __device__ __forceinline__ void a_ready(const Unit&) const {}
    __device__ __forceinline__ void done(const Unit&) const {}
};
struct CountedOrder : StaticOrder {
    const unsigned* ready; unsigned need; unsigned* tmo;
    __device__ __forceinline__ void a_ready(const Unit& u) const {
        if (threadIdx.x < 64) {
            const unsigned long long t0 = __builtin_amdgcn_s_memrealtime(); unsigned polls = 0;
            while ((unsigned)__builtin_amdgcn_readfirstlane(__hip_atomic_load(ready + 64 * u.pm, __ATOMIC_RELAXED, __HIP_MEMORY_SCOPE_AGENT)) < need) {
                if ((++polls & 255u) == 0u && __builtin_amdgcn_readfirstlane(__hip_atomic_load(tmo, __ATOMIC_RELAXED, __HIP_MEMORY_SCOPE_AGENT)) != 0u) break;
                if (__builtin_amdgcn_s_memrealtime() - t0 > 2000000ull) {
                    if (threadIdx.x == 0) { unsigned expect = 0u; __hip_atomic_compare_exchange_strong(tmo + 1, &expect, 0x600u | (unsigned)(u.pm & 0xff), __ATOMIC_RELAXED, __ATOMIC_RELAXED, __HIP_MEMORY_SCOPE_AGENT); __hip_atomic_store(tmo, 1u, __ATOMIC_RELAXED, __HIP_MEMORY_SCOPE_AGENT); }
                    break; }
                __builtin_amdgcn_s_sleep(2); }
            __builtin_amdgcn_fence(__ATOMIC_ACQUIRE, "agent");
            asm volatile("s_waitcnt vmcnt(0)" ::: "memory");
        }
#if !defined(BROKEN_HOOK_NO_BARRIER)
        asm volatile("" ::: "memory"); __builtin_amdgcn_s_barrier(); asm volatile("" ::: "memory");
#endif
    }
};

__device__ __forceinline__ unsigned cvt_pk_bf16(float lo, float hi) { unsigned r; asm volatile("v_cvt_pk_bf16_f32 %0, %1, %2" : "=v"(r) : "v"(lo), "v"(hi)); return r; }
typedef float f32x2 __attribute__((ext_vector_type(2)));
__device__ __forceinline__ f32x2 gelu_pk(f32x2 v) {
    const f32x2 av = __builtin_elementwise_abs(v), d = av * 0.2316418882f + 1.0f;
    f32x2 t; t.x = __builtin_amdgcn_rcpf(d.x); t.y = __builtin_amdgcn_rcpf(d.y);
    f32x2 q = t * 0.5307027145f + (-0.7265760135f); q = q * t + 0.7107068705f; q = q * t + (-0.142248368f); q = q * t + 0.127414796f; q = q * t;
    const f32x2 s = (v * v) * (-0.72134752044f);
    f32x2 e; e.x = __builtin_amdgcn_exp2f(s.x); e.y = __builtin_amdgcn_exp2f(s.y);
    const f32x2 m = v * (q * e), r = v - m;
    f32x2 o; o.x = v.x < 0.f ? m.x : r.x; o.y = v.y < 0.f ? m.y : r.y; return o;
}

struct EpiF32 {
    static constexpr bool PERM = false, AFTER_DRAIN = false;
    float* C; int ldc; const float* bias;
    __device__ __forceinline__ void operator()(const f32x4 (&acc)[2][2][4][2], const Unit& u, int wr, int wc, int fr, int fq) const {
        const int row0 = u.pm * BM + wr * 64 + fr, col0 = u.pn * BM + wc * 32 + 4 * fq;
        f32x4 bv[2][2];
#pragma unroll
        for (int bj = 0; bj < 2; ++bj)
#pragma unroll
            for (int n = 0; n < 2; ++n) bv[bj][n] = bias ? *(const f32x4*)(bias + col0 + bj * HALF + n * 16) : (f32x4){0.f, 0.f, 0.f, 0.f};
#pragma unroll
        for (int ai = 0; ai < 2; ++ai)
#pragma unroll
            for (int m = 0; m < 4; ++m) { float* rowp = C + (size_t)(row0 + ai * HALF + m * 16) * ldc + col0;
#pragma unroll
                for (int bj = 0; bj < 2; ++bj)
#pragma unroll
                    for (int n = 0; n < 2; ++n) *(f32x4*)(rowp + bj * HALF + n * 16) = acc[ai][bj][m][n] + bv[bj][n]; }
    }
};
template <int ACT  > struct EpiBf16 {
    static constexpr bool PERM = true, AFTER_DRAIN = false;
    bf16_t* O; int ldc; const float* bias; int split_cols; size_t split_stride;
    __device__ __forceinline__ void operator()(const f32x4 (&acc)[2][2][4][2], const Unit& u, int wr, int wc, int fr, int fq) const {
        const int row0 = u.pm * BM + wr * 64 + fr; int colt = u.pn * BM; bf16_t* base = O;
        if (split_cols) { const int t = colt / split_cols; base += (size_t)t * split_stride; colt -= t * split_cols; }
        const int col0 = colt + wc * 32 + 8 * fq, bcol0 = u.pn * BM + wc * 32 + 8 * fq;
        f32x4 bv[2][2];
#pragma unroll
        for (int bj = 0; bj < 2; ++bj)
#pragma unroll
            for (int n = 0; n < 2; ++n) bv[bj][n] = bias ? *(const f32x4*)(bias + bcol0 + bj * HALF + 4 * n) : (f32x4){0.f, 0.f, 0.f, 0.f};
#pragma unroll
        for (int ai = 0; ai < 2; ++ai)
#pragma unroll
            for (int m = 0; m < 4; ++m) { bf16_t* rowp = base + (size_t)(row0 + ai * HALF + m * 16) * ldc + col0;
#pragma unroll
                for (int bj = 0; bj < 2; ++bj) { f32x4 v0 = acc[ai][bj][m][0] + bv[bj][0], v1 = acc[ai][bj][m][1] + bv[bj][1];
                    if (ACT == 1) { f32x2 a = gelu_pk((f32x2){v0[0], v0[1]}), b = gelu_pk((f32x2){v0[2], v0[3]}), c = gelu_pk((f32x2){v1[0], v1[1]}), d = gelu_pk((f32x2){v1[2], v1[3]});
                        v0 = (f32x4){a.x, a.y, b.x, b.y}; v1 = (f32x4){c.x, c.y, d.x, d.y}; }
                    if (ACT == 2) {
#pragma unroll
                        for (int j = 0; j < 4; ++j) { v0[j] = 0.5f * v0[j] * (1.0f + erff(v0[j] * 0.70710678f)); v1[j] = 0.5f * v1[j] * (1.0f + erff(v1[j] * 0.70710678f)); } }
                    u32x4 w; w.x = cvt_pk_bf16(v0[0], v0[1]); w.y = cvt_pk_bf16(v0[2], v0[3]); w.z = cvt_pk_bf16(v1[0], v1[1]); w.w = cvt_pk_bf16(v1[2], v1[3]);
                    *(u32x4*)(rowp + bj * HALF) = w; } }
    }
};
struct EpiF32Res {
    static constexpr bool PERM = false, AFTER_DRAIN = false;
    float* C; int ldc; const float* res;
    __device__ __forceinline__ void operator()(const f32x4 (&acc)[2][2][4][2], const Unit& u, int wr, int wc, int fr, int fq) const {
        const int row0 = u.pm * BM + wr * 64 + fr, col0 = u.pn * BM + wc * 32 + 4 * fq;
#pragma unroll
        for (int ai = 0; ai < 2; ++ai)
#pragma unroll
            for (int m = 0; m < 4; ++m) { const size_t off = (size_t)(row0 + ai * HALF + m * 16) * ldc + col0;
#pragma unroll
                for (int bj = 0; bj < 2; ++bj)
#pragma unroll
                    for (int n = 0; n < 2; ++n) { const f32x4 rv = *(const f32x4*)(res + off + bj * HALF + n * 16); *(f32x4*)(C + off + bj * HALF + n * 16) = acc[ai][bj][m][n] + rv; } }
    }
};
template <class Epi, class Sched, bool STAMP = false>
__device__ __forceinline__ void gemm_phase(PG8_LAS unsigned char* lds, const Gemm g, const Sched& S, const Epi& E, unsigned long long* stamps) {
    const int tid = threadIdx.x, wid = __builtin_amdgcn_readfirstlane(tid >> 6), lane = tid & 63, wr = wid >> 2, wc = wid & 3, fr = lane & 15, fq = lane >> 4;
    const int K = g.K, nt = K / BK;
    int ts_lo = 0, ts_hi = 0, nts = 0; const unsigned long long rt_entry = STAMP ? (unsigned long long)wall_clock64() : 0ull;
#define PG8_STAMP() do { if (STAMP && wid == 0 && nts < 64) { const unsigned long long _c = (unsigned long long)clock64(); \
        ts_lo = (lane == nts) ? (int)(unsigned)_c : ts_lo; ts_hi = (lane == nts) ? (int)(unsigned)(_c >> 32) : ts_hi; ++nts; } } while (0)
    PG8_STAMP();
    unsigned voffA[2], voffB[2];
#pragma unroll
    for (int i = 0; i < 2; ++i) { int R, C; stage_rc(tid * 16 + i * 8192, R, C); const int Rb = Epi::PERM ? ((R & ~31) + perm32(R & 31)) : R;
        voffA[i] = (unsigned)(R * K + C) * 2u; voffB[i] = (unsigned)(Rb * K + C) * 2u; }
    const size_t kstep = (size_t)(BK * 2);
    const size_t hstep = (size_t)HALF * K * 2;
    const size_t tstep = 2 * hstep;
    const unsigned ldsw = (unsigned)wid * 1024u;
    const int aoff = lds_byte(wr * 64 + fr, fq * 8), boff = lds_byte(wc * 32 + fr, fq * 8);
#define PG8_SA(b, h) (((b) * 2 + (h)) * HTB)
#define PG8_SB(b, h) ((4 + (b) * 2 + (h)) * HTB)
#define PG8_STAGE(bufoff, gbase, voff) do { _Pragma("unroll") for (int _i = 0; _i < 2; ++_i) \
        __builtin_amdgcn_global_load_lds((const unsigned*)((const char*)(gbase) + (voff)[_i]), (PG8_LAS unsigned*)(lds + (bufoff) + ldsw + _i * 8192), 16, 0, 0); } while (0)
#define PG8_LDA(dst, b, h) do { _Pragma("unroll") for (int m = 0; m < 4; ++m) _Pragma("unroll") for (int k = 0; k < 2; ++k) dst[m][k] = *(const PG8_LAS bf16x8*)(lds + PG8_SA(b, h) + aoff + m * 2048 + k * 1024); } while (0)
#define PG8_LDB(dst, b, h) do { _Pragma("unroll") for (int n = 0; n < 2; ++n) _Pragma("unroll") for (int k = 0; k < 2; ++k) dst[n][k] = *(const PG8_LAS bf16x8*)(lds + PG8_SB(b, h) + boff + n * 2048 + k * 1024); } while (0)
#define PG8_MMA(ai, bj, At, Bt) do { __builtin_amdgcn_s_setprio(1); _Pragma("unroll") for (int m = 0; m < 4; ++m) _Pragma("unroll") for (int n = 0; n < 2; ++n) _Pragma("unroll") for (int k = 0; k < 2; ++k) \
        acc[ai][bj][m][n] = __builtin_amdgcn_mfma_f32_16x16x32_bf16(Bt[n][k], At[m][k], acc[ai][bj][m][n], 0, 0, 0); __builtin_amdgcn_s_setprio(0); } while (0)
#define PG8_WAIT_V(n) asm volatile("s_waitcnt vmcnt(" #n ")" ::: "memory")
#define PG8_WAIT_L(n) asm volatile("s_waitcnt lgkmcnt(" #n ")" ::: "memory")
#define PG8_BAR __builtin_amdgcn_s_barrier()
#define PG8_SCHED __builtin_amdgcn_sched_barrier(0)
    Unit cur, nxt; int ui = 0;
    if (!S.next(0, cur)) return;
    f32x4 acc[2][2][4][2];
#pragma unroll
    for (int a = 0; a < 2; ++a)
#pragma unroll
        for (int b = 0; b < 2; ++b)
#pragma unroll
            for (int m = 0; m < 4; ++m)
#pragma unroll
                for (int n = 0; n < 2; ++n) acc[a][b][m][n] = (f32x4){0.f, 0.f, 0.f, 0.f};
    bf16x8 At[4][2], B0[2][2], B1[2][2];
    const char* cA = (const char*)g.A + (size_t)cur.pm * tstep; const char* cB = (const char*)g.Bt + (size_t)cur.pn * tstep;
    S.a_ready(cur);
    PG8_STAGE(PG8_SB(0, 0), cB, voffB); PG8_STAGE(PG8_SA(0, 0), cA, voffA); PG8_STAGE(PG8_SB(0, 1), cB + hstep, voffB); PG8_STAGE(PG8_SA(0, 1), cA + hstep, voffA);
    if (wr == 1) PG8_BAR;
    PG8_WAIT_V(4); PG8_BAR;
    PG8_STAGE(PG8_SB(1, 0), cB + kstep, voffB); PG8_STAGE(PG8_SA(1, 0), cA + kstep, voffA); PG8_STAGE(PG8_SB(1, 1), cB + hstep + kstep, voffB);
    PG8_WAIT_V(6); PG8_BAR;
    PG8_STAMP();
    for (;;) {
        const bool has_next = S.next(ui + 1, nxt);
        const char* nA = has_next ? (const char*)g.A + (size_t)nxt.pm * tstep : cA; const char* nB = has_next ? (const char*)g.Bt + (size_t)nxt.pn * tstep : cB;
        for (int t = 0; t < nt; t += 2) {
            const bool last = (t == nt - 2);
            const char* a1 = cA + (size_t)(t + 1) * kstep;
            const char* a2 = last ? nA : cA + (size_t)(t + 2) * kstep; const char* b2 = last ? nB : cB + (size_t)(t + 2) * kstep;
            const char* a3 = a2 + kstep; const char* b3 = b2 + kstep;
            if (last && has_next) S.a_ready(nxt);
            PG8_LDB(B0, 0, 0); PG8_SCHED; PG8_LDA(At, 0, 0); PG8_STAGE(PG8_SA(1, 1), a1 + hstep, voffA);
            PG8_WAIT_L(8); PG8_BAR; PG8_WAIT_L(0); PG8_MMA(0, 0, At, B0); PG8_BAR; PG8_SCHED;
            PG8_LDB(B1, 0, 1); PG8_STAGE(PG8_SB(0, 0), b2, voffB);
            PG8_BAR; PG8_WAIT_L(0); PG8_MMA(0, 1, At, B1); PG8_BAR;
            PG8_LDA(At, 0, 1); PG8_STAGE(PG8_SA(0, 0), a2, voffA);
            PG8_BAR; PG8_WAIT_L(0); PG8_MMA(1, 0, At, B0); PG8_BAR; PG8_SCHED;
            PG8_STAGE(PG8_SB(0, 1), b2 + hstep, voffB);
            PG8_WAIT_V(6); PG8_BAR; PG8_MMA(1, 1, At, B1); PG8_BAR;
            PG8_LDB(B0, 1, 0); PG8_SCHED; PG8_LDA(At, 1, 0); PG8_STAGE(PG8_SA(0, 1), a2 + hstep, voffA);
            PG8_WAIT_L(8); PG8_BAR; PG8_WAIT_L(0); PG8_MMA(0, 0, At, B0); PG8_BAR; PG8_SCHED;
            PG8_LDB(B1, 1, 1); PG8_STAGE(PG8_SB(1, 0), b3, voffB);
            PG8_BAR; PG8_WAIT_L(0); PG8_MMA(0, 1, At, B1); PG8_BAR;
            PG8_LDA(At, 1, 1); PG8_STAGE(PG8_SA(1, 0), a3, voffA);
            PG8_BAR; PG8_WAIT_L(0); PG8_MMA(1, 0, At, B0); PG8_BAR; PG8_SCHED;
            PG8_STAGE(PG8_SB(1, 1), b3 + hstep, voffB);
            PG8_WAIT_V(6); PG8_BAR; PG8_MMA(1, 1, At, B1); PG8_BAR;
        }
        PG8_STAMP();
        if constexpr (!Epi::AFTER_DRAIN) { E(acc, cur, wr, wc, fr, fq); S.done(cur); }
        PG8_STAMP();
        if (!has_next) break;
#pragma unroll
        for (int a = 0; a < 2; ++a)
#pragma unroll
            for (int b = 0; b < 2; ++b)
#pragma unroll
                for (int m = 0; m < 4; ++m)
#pragma unroll
                    for (int n = 0; n < 2; ++n) acc[a][b][m][n] = (f32x4){0.f, 0.f, 0.f, 0.f};
        cur = nxt; cA = nA; cB = nB; ++ui;
    }
    PG8_WAIT_V(0);
    if (wr == 0) PG8_BAR;
    PG8_BAR;
    if constexpr (Epi::AFTER_DRAIN) { E.fused(acc, cur, wr, wc, fr, fq, lds, wid, lane); S.done(cur); }
    PG8_STAMP();
    if (STAMP && wid == 0) { stamps[lane] = lane < nts ? (((unsigned long long)(unsigned)ts_hi << 32) | (unsigned)ts_lo) : 0ull;
        if (lane == 62) stamps[62] = rt_entry; if (lane == 63) stamps[63] = (unsigned long long)wall_clock64(); }
#undef PG8_STAMP
#undef PG8_SA
#undef PG8_SB
#undef PG8_STAGE
#undef PG8_LDA
#undef PG8_LDB
#undef PG8_MMA
#undef PG8_WAIT_V
#undef PG8_WAIT_L
#undef PG8_BAR
#undef PG8_SCHED
}
}
#define LAS __attribute__((address_space(3)))
typedef unsigned short bf16;
typedef short bf16x8 __attribute__((ext_vector_type(8)));
typedef short s16x4 __attribute__((ext_vector_type(4)));
typedef float f32x16 __attribute__((ext_vector_type(16)));
typedef float f32x4 __attribute__((ext_vector_type(4)));
typedef unsigned u32x4 __attribute__((ext_vector_type(4)));
typedef unsigned u32x2 __attribute__((ext_vector_type(2)));

constexpr int S = 8192, DM = 4096, NIN = 7240, NINP = 7424, DFF = 11008, DFF2 = 22016;
constexpr int C_Q = 1024, C_KC = 4096, C_VC = 4608, C_KS = 5120, C_VS = 5632, C_KW = 6144, C_VW = 6656, C_GL = 7168;
constexpr float LOG2E = 1.4426950408889634f;
constexpr float C2S = 0.08838834764831845f * 1.4426950408889634f;
constexpr float RMS_EPS = 1e-6f;

constexpr size_t MiB = 1u << 20;
constexpr size_t WS_CTL = 0, CTL_BYTES = 4096;
constexpr size_t WS_WIN_T = 1 * MiB;
constexpr size_t WS_WOUT_T = 59 * MiB;
constexpr size_t WS_WUP_T = 91 * MiB;
constexpr size_t WS_WDN_T = 263 * MiB;
constexpr size_t WS_SMALL = 349 * MiB;
constexpr size_t WS_PWT = WS_SMALL;
constexpr size_t WS_W1KT = WS_SMALL + 1 * MiB;
constexpr size_t WS_W1VT = WS_SMALL + 2 * MiB;
constexpr size_t WS_W2KT = WS_SMALL + 3 * MiB;
constexpr size_t WS_W2VT = WS_SMALL + 3 * MiB + 65536;
constexpr size_t WS_C1P = WS_SMALL + 3 * MiB + 131072;
constexpr size_t WS_CK = WS_SMALL + 4 * MiB;
constexpr size_t WS_CV = WS_SMALL + 5 * MiB;
constexpr size_t WS_SEL = WS_SMALL + 6 * MiB;
constexpr size_t WS_HN = 357 * MiB;
constexpr size_t WS_PROJ = 421 * MiB;
constexpr size_t WS_MIX = 537 * MiB;
constexpr size_t WS_ACT = WS_PROJ;
constexpr size_t WS_SCR = 601 * MiB;
constexpr size_t WS_H1 = 665 * MiB;
constexpr size_t WS_U = 793 * MiB;
constexpr size_t WS_END = 1137 * MiB;

constexpr int RING_BYTES = 131072;
constexpr int LDS_BIAS = RING_BYTES;
constexpr int LDS_AL = LDS_BIAS + 24 * 128 * 4;
constexpr int LDS_MISC = LDS_AL + 8 * 64 * 4;
constexpr int LDS_BYTES = 147456;
static_assert(LDS_MISC + 64 <= LDS_BYTES, "lds map");

struct Params { const float* in[19]; float* out; unsigned char* ws; int ph_lo, ph_hi; };

#define LDS_WAIT() asm volatile("s_waitcnt lgkmcnt(0)" ::: "memory")
__device__ __forceinline__ unsigned cvtpk(float lo, float hi) { unsigned r; asm volatile("v_cvt_pk_bf16_f32 %0, %1, %2" : "=v"(r) : "v"(lo), "v"(hi)); return r; }
__device__ __forceinline__ float bf2f(unsigned short b) { return __uint_as_float(((unsigned)b) << 16); }
__device__ __forceinline__ bf16x8 pack8(f32x4 a, f32x4 b) { u32x4 w = {cvtpk(a[0], a[1]), cvtpk(a[2], a[3]), cvtpk(b[0], b[1]), cvtpk(b[2], b[3])}; return __builtin_bit_cast(bf16x8, w); }
__device__ __forceinline__ bf16x8 ld8(const bf16* p) { return *reinterpret_cast<const bf16x8*>(p); }
__device__ __forceinline__ float wave_sum(float v) {
#pragma unroll
    for (int o = 1; o < 64; o <<= 1) v += __shfl_xor(v, o);
    return v;
}
__device__ __forceinline__ float sigmoidf_(float x) { return 1.f / (1.f + __expf(-x)); }

__device__ __forceinline__ void tr_item(const float* __restrict__ W, int K, int N, bf16* __restrict__ WT, LAS float* scr, int item, int lane) {
    const int nblk = (N + 31) >> 5, kb = item / nblk, nb = item - kb * nblk, k0 = 64 * kb, n0 = 32 * nb;
    const int nn = n0 + (lane & 31); const bool ok = nn < N;
#pragma unroll 8
    for (int i = 0; i < 32; ++i) { const int kk = 2 * i + (lane >> 5); scr[kk * 33 + (lane & 31)] = ok ? W[(size_t)(k0 + kk) * N + nn] : 0.f; }
    LDS_WAIT(); asm volatile("" ::: "memory");
    const int c = lane & 7;
#pragma unroll
    for (int j = 0; j < 4; ++j) { const int n = (lane >> 3) + 8 * j; const LAS float* s = scr + (8 * c) * 33 + n;
        u32x4 o; o.x = cvtpk(s[0 * 33], s[1 * 33]); o.y = cvtpk(s[2 * 33], s[3 * 33]); o.z = cvtpk(s[4 * 33], s[5 * 33]); o.w = cvtpk(s[6 * 33], s[7 * 33]);
        if (n0 + n < N) *(u32x4*)(WT + (size_t)(n0 + n) * K + k0 + 8 * c) = o; }
    LDS_WAIT(); asm volatile("" ::: "memory");
}
__device__ __forceinline__ void rms_row_bf16(const float* __restrict__ xrow, const float* __restrict__ g, bf16* __restrict__ orow, int lane) {
    const f32x4* xr = (const f32x4*)xrow + lane; f32x4 v[16]; float s = 0.f;
#pragma unroll
    for (int j = 0; j < 16; ++j) { v[j] = xr[64 * j]; s += (v[j].x * v[j].x + v[j].y * v[j].y) + (v[j].z * v[j].z + v[j].w * v[j].w); }
    const float r = rsqrtf(wave_sum(s) * (1.f / DM) + RMS_EPS);
    const f32x4* gr = (const f32x4*)g + lane; u32x2* o8 = (u32x2*)orow + lane;
#pragma unroll
    for (int j = 0; j < 16; ++j) { const f32x4 gv = gr[64 * j]; u32x2 w; w.x = cvtpk(v[j].x * r * gv.x, v[j].y * r * gv.y); w.y = cvtpk(v[j].z * r * gv.z, v[j].w * r * gv.w); o8[64 * j] = w; }
}
__device__ __forceinline__ void rms_row_f32(const float* xrow, const float* __restrict__ g, float* orow, int lane) {
    const f32x4* xr = (const f32x4*)xrow + lane; f32x4 v[16]; float s = 0.f;
#pragma unroll
    for (int j = 0; j < 16; ++j) { v[j] = xr[64 * j]; s += (v[j].x * v[j].x + v[j].y * v[j].y) + (v[j].z * v[j].z + v[j].w * v[j].w); }
    const float r = rsqrtf(wave_sum(s) * (1.f / DM) + RMS_EPS);
    const f32x4* gr = (const f32x4*)g + lane; f32x4* o = (f32x4*)orow + lane;
#pragma unroll
    for (int j = 0; j < 16; ++j) { const f32x4 gv = gr[64 * j]; o[64 * j] = v[j] * r * gv; }
}

#define KSWZ(row, colB) ((row) * 256 + ((colB) ^ (((row) & 7) << 4)))
#define SBAR() __builtin_amdgcn_sched_barrier(0)
constexpr int SHM_V = 16384, SHM_K = 16384;
__device__ __forceinline__ int v_st(int k, int c) { const int kk = (k & ~0xC) | ((k & 4) << 1) | ((k & 8) >> 1); return ((kk >> 3) * 4 + (c >> 5)) * 512 + ((kk & 7) * 32 + (c & 31)) * 2; }
__device__ __forceinline__ int v_rd_base(int lane) { return ((lane & 3) << 3) | (((lane >> 2) & 3) << 6) | (((lane >> 4) & 1) << 5) | (((lane >> 5) & 1) << 8); }
constexpr int v_rd_off(int d0, int ks, int half) { return d0 * 512 + ks * 4096 + half * 2048; }
__device__ __forceinline__ int crow(int r, int hi) { return (r & 3) + 8 * (r >> 2) + 4 * hi; }

template <int MODE>
__device__ __forceinline__ void score_tile(f32x16& p0, f32x16& p1, int dq, const LAS float* brow, float b31, bool far, bool sel) {
    const float NEG = -__builtin_inff();
    if (far) {
#pragma unroll
        for (int r = 0; r < 16; ++r) {
            const int c = (r & 3) + 8 * (r >> 2);
            const int d0 = (MODE == 0) ? dq - 16 * c : dq - c, d1 = (MODE == 0) ? d0 - 512 : d0 - 32;
            bool v0, v1;
            if (MODE == 0) { v0 = d0 >= 0; v1 = d1 >= 0; } else if (MODE == 1) { v0 = sel && d0 >= 0; v1 = sel && d1 >= 0; } else { v0 = (unsigned)d0 < 512u; v1 = (unsigned)d1 < 512u; }
            p0[r] = v0 ? fmaf(p0[r], C2S, b31) : NEG; p1[r] = v1 ? fmaf(p1[r], C2S, b31) : NEG;
        }
    } else {
#pragma unroll
        for (int r = 0; r < 16; ++r) {
            const int c = (r & 3) + 8 * (r >> 2);
            const int d0 = (MODE == 0) ? dq - 16 * c : dq - c, d1 = (MODE == 0) ? d0 - 512 : d0 - 32;
            bool v0, v1;
            if (MODE == 0) { v0 = d0 >= 0; v1 = d1 >= 0; } else if (MODE == 1) { v0 = sel && d0 >= 0; v1 = sel && d1 >= 0; } else { v0 = (unsigned)d0 < 512u; v1 = (unsigned)d1 < 512u; }
            const float bb0 = brow[min(max(d0, 0), 127)];
            p0[r] = v0 ? fmaf(p0[r], C2S, bb0) : NEG; (void)v1;
        }
        SBAR();
#pragma unroll
        for (int r = 0; r < 16; ++r) {
            const int c = (r & 3) + 8 * (r >> 2);
            const int d0 = (MODE == 0) ? dq - 16 * c : dq - c, d1 = (MODE == 0) ? d0 - 512 : d0 - 32;
            bool v1;
            if (MODE == 0) { v1 = d1 >= 0; } else if (MODE == 1) { v1 = sel && d1 >= 0; } else { v1 = (unsigned)d1 < 512u; }
            const float bb1 = brow[min(max(d1, 0), 127)];
            p1[r] = v1 ? fmaf(p1[r], C2S, bb1) : NEG;
        }
    }
}
__device__ __forceinline__ float half_max(float v) { auto rr = __builtin_amdgcn_permlane32_swap(__float_as_uint(v), __float_as_uint(v), false, false); return fmaxf(__uint_as_float(rr[0]), __uint_as_float(rr[1])); }
__device__ __forceinline__ float half_sum(float v) { auto rr = __builtin_amdgcn_permlane32_swap(__float_as_uint(v), __float_as_uint(v), false, false); return __uint_as_float(rr[0]) + __uint_as_float(rr[1]); }

__device__ __forceinline__ void pv_tile(f32x16 (&o)[4], int vb0, bf16x8 pa0, bf16x8 pa1, bf16x8 pa2, bf16x8 pa3) {
#define TRRD(dst, off) asm volatile("ds_read_b64_tr_b16 %0, %1 offset:%2" : "=&v"(dst) : "v"(vb0), "i"(off) : "memory")
#define PV_D0(d0) do { s16x4 l0, l1, l2, l3, h0, h1, h2, h3; constexpr int b_ = v_rd_off(d0, 0, 0); \
        TRRD(l0, b_); TRRD(h0, b_ + 2048); TRRD(l1, b_ + 4096); TRRD(h1, b_ + 6144); TRRD(l2, b_ + 8192); TRRD(h2, b_ + 10240); TRRD(l3, b_ + 12288); TRRD(h3, b_ + 14336); \
        asm volatile("s_waitcnt lgkmcnt(0)" ::: "memory"); SBAR(); \
        o[d0] = __builtin_amdgcn_mfma_f32_32x32x16_bf16(pa0, (bf16x8){l0[0], l0[1], l0[2], l0[3], h0[0], h0[1], h0[2], h0[3]}, o[d0], 0, 0, 0); \
        o[d0] = __builtin_amdgcn_mfma_f32_32x32x16_bf16(pa1, (bf16x8){l1[0], l1[1], l1[2], l1[3], h1[0], h1[1], h1[2], h1[3]}, o[d0], 0, 0, 0); \
        o[d0] = __builtin_amdgcn_mfma_f32_32x32x16_bf16(pa2, (bf16x8){l2[0], l2[1], l2[2], l2[3], h2[0], h2[1], h2[2], h2[3]}, o[d0], 0, 0, 0); \
        o[d0] = __builtin_amdgcn_mfma_f32_32x32x16_bf16(pa3, (bf16x8){l3[0], l3[1], l3[2], l3[3], h3[0], h3[1], h3[2], h3[3]}, o[d0], 0, 0, 0); } while (0)
    PV_D0(0); PV_D0(1); PV_D0(2); PV_D0(3);
#undef PV_D0
#undef TRRD
}

template <int MODE>
__device__ __forceinline__ void attn_tile(const LAS char* Kb, int vb0, const bf16x8 (&qr)[8], int r32, int hi, int dq, const LAS float* brow, float b31, bool far, bool sel,
                                          float& m_reg, float& l_reg, f32x16 (&o)[4], LAS float* al_l) {
    f32x16 p0 = {}, p1 = {};
    const LAS char* kbp[4];
#pragma unroll
    for (int dd = 0; dd < 4; ++dd) kbp[dd] = Kb + KSWZ(r32, (dd * 16 + hi * 8) * 2);
#pragma unroll
    for (int d0 = 0; d0 < 8; ++d0) { const LAS char* a = kbp[d0 & 3] + (d0 >> 2) * 128;
        const bf16x8 b0 = *reinterpret_cast<const LAS bf16x8*>(a), b1 = *reinterpret_cast<const LAS bf16x8*>(a + 32 * 256);
        p0 = __builtin_amdgcn_mfma_f32_32x32x16_bf16(b0, qr[d0], p0, 0, 0, 0);
        p1 = __builtin_amdgcn_mfma_f32_32x32x16_bf16(b1, qr[d0], p1, 0, 0, 0); }
    score_tile<MODE>(p0, p1, dq, brow, b31, far, sel);
    float pmax = p0[0];
#pragma unroll
    for (int r = 1; r < 16; ++r) pmax = fmaxf(pmax, p0[r]);
#pragma unroll
    for (int r = 0; r < 16; ++r) pmax = fmaxf(pmax, p1[r]);
    pmax = half_max(pmax);
    const float mn = fmaxf(m_reg, pmax), alpha = __builtin_amdgcn_exp2f(m_reg - mn); m_reg = mn;
    float ps = 0.f;
#pragma unroll
    for (int r = 0; r < 16; ++r) { p0[r] = __builtin_amdgcn_exp2f(p0[r] - mn); ps += p0[r]; }
#pragma unroll
    for (int r = 0; r < 16; ++r) { p1[r] = __builtin_amdgcn_exp2f(p1[r] - mn); ps += p1[r]; }
    ps = half_sum(ps);
    l_reg = l_reg * alpha + ps;
    if (__any(alpha < 1.f)) { if (hi == 0) al_l[r32] = alpha; LDS_WAIT();
#pragma unroll
        for (int r = 0; r < 16; ++r) { const float a = al_l[crow(r, hi)];
#pragma unroll
            for (int d = 0; d < 4; ++d) o[d][r] *= a; }
        LDS_WAIT(); }
    bf16x8 pa0, pa1, pa2, pa3;
#define PK4(P, B_, OUT) do { unsigned a0 = cvtpk(P[B_+0], P[B_+1]), a1 = cvtpk(P[B_+2], P[B_+3]); \
        unsigned b0_ = cvtpk(P[B_+4], P[B_+5]), b1_ = cvtpk(P[B_+6], P[B_+7]); \
        auto r0 = __builtin_amdgcn_permlane32_swap(a0, b0_, false, false); auto r1 = __builtin_amdgcn_permlane32_swap(a1, b1_, false, false); \
        u32x4 w = {r0[0], r1[0], r0[1], r1[1]}; OUT = __builtin_bit_cast(bf16x8, w); } while (0)
    PK4(p0, 0, pa0); PK4(p0, 8, pa1); PK4(p1, 0, pa2); PK4(p1, 8, pa3);
#undef PK4
    pv_tile(o, vb0, pa0, pa1, pa2, pa3);
}

template <int MODE>
__device__ __forceinline__ void attn_branch(const bf16* __restrict__ Kp, const bf16* __restrict__ Vp, int stride, int j_lo, int j_hi, LAS unsigned char* lds,
                                            const bf16x8 (&qr)[8], int tq0, int tpos, const LAS float* brow, float b31, u32x4 selw,
                                            float& m_reg, float& l_reg, f32x16 (&o)[4], LAS float* al_l, int tid, int lane) {
    const int r32 = lane & 31, hi = lane >> 5, sr = tid >> 4, sc = (tid & 15) * 8;
    const int kws = KSWZ(sr, sc * 2), vst0 = v_st(sr, sc), vst1 = v_st(32 + sr, sc);
    m_reg = -1e30f; l_reg = 0.f;
#pragma unroll
    for (int d = 0; d < 4; ++d) o[d] = f32x16{};
    bf16x8 sk0, sk1, sv0, sv1;
#define BLOAD(j) do { const size_t r0_ = (size_t)((j) * 64 + sr) * stride + sc, r1_ = r0_ + (size_t)32 * stride; \
        sk0 = ld8(Kp + r0_); sk1 = ld8(Kp + r1_); sv0 = ld8(Vp + r0_); sv1 = ld8(Vp + r1_); } while (0)
    BLOAD(j_lo);
    for (int j = j_lo; j < j_hi; ++j) {
        const int buf = (j - j_lo) & 1;
        LAS char* Vb = (LAS char*)lds + buf * SHM_V; LAS char* Kb = (LAS char*)lds + 2 * SHM_V + buf * SHM_K;
        *reinterpret_cast<LAS bf16x8*>(Kb + kws) = sk0; *reinterpret_cast<LAS bf16x8*>(Kb + kws + 32 * 256) = sk1;
        *reinterpret_cast<LAS bf16x8*>(Vb + vst0) = sv0; *reinterpret_cast<LAS bf16x8*>(Vb + vst1) = sv1;
        __syncthreads();
        if (j + 1 < j_hi) BLOAD(j + 1);
        const int kb = j * 64;
        bool skip, far, sel = true; int dq;
        if (MODE == 0) { skip = 16 * kb > tq0; far = (tq0 - 31 - 16 * (kb + 63)) >= 127; dq = tpos - 31 - 16 * kb - 64 * hi; }
        else {
            far = (tq0 - (kb + 63)) >= 127; dq = tpos - kb - 4 * hi;
            if (MODE == 1) { const unsigned w = j < 32 ? selw.x : (j < 64 ? selw.y : (j < 96 ? selw.z : selw.w)); sel = (w >> (j & 31)) & 1u; skip = (kb > tq0 + 31) || !__any(sel); }
            else skip = (kb > tq0 + 31) || (kb + 63 < tq0 - 511);
        }
        if (!skip) attn_tile<MODE>(Kb, (int)(size_t)Vb + v_rd_base(lane), qr, r32, hi, dq, brow, b31, far, sel, m_reg, l_reg, o, al_l);
    }
    __syncthreads();
#undef BLOAD
}

__device__ __forceinline__ void compress_unit(int u, const bf16* __restrict__ proj, unsigned char* ws, LAS unsigned char* lds, int tid, int wid, int lane) {
    const int which = u >> 6, g = (u >> 4) & 3, nb = u & 15, fr = lane & 15, fq = lane >> 4, e0 = wid * 16;
    const bf16* src = proj + (which ? C_VC : C_KC) + g * 128;
    const bf16* w1t = (const bf16*)(ws + (which ? WS_W1VT : WS_W1KT));
    const bf16* w2t = (const bf16*)(ws + (which ? WS_W2VT : WS_W2KT));
    const float* c1p = (const float*)(ws + WS_C1P) + which * 32 * 128;
    bf16* outp = (bf16*)(ws + (which ? WS_CV : WS_CK)) + (size_t)g * 512 * 128;
    LAS float* c1s = (LAS float*)lds; LAS bf16* hs = (LAS bf16*)(lds + 1024);
    if (tid < 128) { float s = 0.f; for (int r = 0; r < 32; ++r) s += c1p[r * 128 + tid]; c1s[tid] = s; }
    __syncthreads();
    const int na = nb * 32 + fr, nb_ = na + 16;
    const bf16* a0p = src + (size_t)(16 * min(na, 510)) * NINP + fq * 8;
    const bf16* a1p = src + (size_t)(16 * min(nb_, 510)) * NINP + fq * 8;
    const bf16* bp = w1t + (size_t)(e0 + fr) * 4096 + fq * 8;
    f32x4 acc0 = {0.f, 0.f, 0.f, 0.f}, acc1 = {0.f, 0.f, 0.f, 0.f};
#pragma unroll 2
    for (int l = 0; l < 32; ++l) {
#pragma unroll
        for (int k4 = 0; k4 < 4; ++k4) {
            const bf16x8 A0 = ld8(a0p + (size_t)l * NINP + k4 * 32), A1 = ld8(a1p + (size_t)l * NINP + k4 * 32), B = ld8(bp + l * 128 + k4 * 32);
            acc0 = __builtin_amdgcn_mfma_f32_16x16x32_bf16(A0, B, acc0, 0, 0, 0);
            acc1 = __builtin_amdgcn_mfma_f32_16x16x32_bf16(A1, B, acc1, 0, 0, 0);
        }
    }
    const float cc = c1s[e0 + fr];
#pragma unroll
    for (int j = 0; j < 4; ++j) {
        float h0 = acc0[j] + cc, h1 = acc1[j] + cc; h0 = h0 * sigmoidf_(h0); h1 = h1 * sigmoidf_(h1);
        hs[(fq * 4 + j) * 136 + e0 + fr] = (bf16)(cvtpk(h0, 0.f) & 0xffffu); hs[(16 + fq * 4 + j) * 136 + e0 + fr] = (bf16)(cvtpk(h1, 0.f) & 0xffffu);
    }
    __syncthreads();
    f32x4 o0 = {0.f, 0.f, 0.f, 0.f}, o1 = {0.f, 0.f, 0.f, 0.f};
#pragma unroll
    for (int ks = 0; ks < 4; ++ks) {
        const bf16x8 A0 = *reinterpret_cast<const LAS bf16x8*>(hs + fr * 136 + ks * 32 + fq * 8), A1 = *reinterpret_cast<const LAS bf16x8*>(hs + (16 + fr) * 136 + ks * 32 + fq * 8);
        const bf16x8 B = ld8(w2t + (size_t)(e0 + fr) * 128 + ks * 32 + fq * 8);
        o0 = __builtin_amdgcn_mfma_f32_16x16x32_bf16(A0, B, o0, 0, 0, 0);
        o1 = __builtin_amdgcn_mfma_f32_16x16x32_bf16(A1, B, o1, 0, 0, 0);
    }
#pragma unroll
    for (int j = 0; j < 4; ++j) {
        const int n0 = nb * 32 + fq * 4 + j, n1 = n0 + 16;
        outp[(size_t)n0 * 128 + e0 + fr] = n0 < 511 ? (bf16)(cvtpk(o0[j], 0.f) & 0xffffu) : (bf16)0;
        outp[(size_t)n1 * 128 + e0 + fr] = n1 < 511 ? (bf16)(cvtpk(o1[j], 0.f) & 0xffffu) : (bf16)0;
    }
    __syncthreads();
}


__device__ __forceinline__ void compress_naive(int u4, const bf16* __restrict__ proj, const float* pek, const float* w1k, const float* w2k, const float* pev, const float* w1v, const float* w2v, unsigned char* ws, LAS unsigned char* lds, int tid) {
    const int which = u4 >> 9, g = (u4 >> 7) & 3, nq = u4 & 127, sub = tid >> 7, e = tid & 127, n = nq * 4 + sub;
    const float* pe = which ? pev : pek; const float* w1 = which ? w1v : w1k; const float* w2 = which ? w2v : w2k;
    const bf16* src = proj + (which ? C_VC : C_KC) + g * 128;
    bf16* outp = (bf16*)(ws + (which ? WS_CV : WS_CK)) + (size_t)g * 512 * 128;
    LAS float* hsn = (LAS float*)lds;
    float acc = 0.f;
    if (n < 511) for (int kk = 0; kk < 4096; ++kk) { const int l = kk >> 7, d = kk & 127; const float a = bf2f(src[(size_t)(16 * n + l) * NINP + d]) + pe[kk]; acc += a * w1[(size_t)kk * 128 + e]; }
    hsn[sub * 128 + e] = acc * sigmoidf_(acc);
    __syncthreads();
    float o = 0.f;
    for (int k = 0; k < 128; ++k) o += hsn[sub * 128 + k] * w2[k * 128 + e];
    outp[(size_t)n * 128 + e] = n < 511 ? (bf16)(cvtpk(o, 0.f) & 0xffffu) : (bf16)0;
    __syncthreads();
}

__device__ __forceinline__ void pool_unit(int u, const bf16* __restrict__ proj, const bf16* __restrict__ pwt, const float* __restrict__ pscale, bf16* __restrict__ mix,
                                          LAS unsigned char* lds, int tid, int wid, int lane) {
    const int tt = u >> 2, gi = u & 3, w = 2 << gi, fr = lane & 15, fq = lane >> 4;
    LAS bf16* dA = (LAS bf16*)lds;
    { const int c8 = tid & 31, tr = tid >> 5; const bf16* up = proj + gi * 256 + c8 * 8;
#pragma unroll 1
      for (int q = 0; q < 4; ++q) { const int t = tt * 64 + tr * 4 + q, lo = max(t + 1 - w, 0);
          float acc[8];
#pragma unroll
          for (int i = 0; i < 8; ++i) acc[i] = 0.f;
          bf16x8 own = {};
#pragma unroll 1
          for (int s = lo; s <= t; ++s) { const bf16x8 v = ld8(up + (size_t)s * NINP);
#pragma unroll
              for (int i = 0; i < 8; ++i) acc[i] += bf2f((unsigned short)v[i]);
              own = v; }
          const float inv = 1.f / (float)(t + 1 - lo); f32x4 d0, d1;
#pragma unroll
          for (int i = 0; i < 4; ++i) { d0[i] = acc[i] * inv - bf2f((unsigned short)own[i]); d1[i] = acc[4 + i] * inv - bf2f((unsigned short)own[4 + i]); }
          *reinterpret_cast<LAS bf16x8*>(dA + (tr * 4 + q) * 264 + c8 * 8) = pack8(d0, d1); } }
    __syncthreads();
    f32x4 acc[4][2];
#pragma unroll
    for (int m = 0; m < 4; ++m)
#pragma unroll
        for (int n = 0; n < 2; ++n) acc[m][n] = (f32x4){0.f, 0.f, 0.f, 0.f};
    const bf16* bp = pwt + (size_t)gi * 65536 + (size_t)(wid * 32 + fr) * 256 + fq * 8;
#pragma unroll
    for (int ks = 0; ks < 8; ++ks) {
        const bf16x8 B0 = ld8(bp + ks * 32), B1 = ld8(bp + 16 * 256 + ks * 32);
#pragma unroll
        for (int m = 0; m < 4; ++m) { const bf16x8 A = *reinterpret_cast<const LAS bf16x8*>(dA + (m * 16 + fr) * 264 + ks * 32 + fq * 8);
            acc[m][0] = __builtin_amdgcn_mfma_f32_16x16x32_bf16(A, B0, acc[m][0], 0, 0, 0);
            acc[m][1] = __builtin_amdgcn_mfma_f32_16x16x32_bf16(A, B1, acc[m][1], 0, 0, 0); }
    }
#pragma unroll
    for (int n = 0; n < 2; ++n) { const int e = wid * 32 + n * 16 + fr; const float sc = pscale[gi * 256 + e];
#pragma unroll
        for (int m = 0; m < 4; ++m)
#pragma unroll
            for (int j = 0; j < 4; ++j) mix[(size_t)(tt * 64 + m * 16 + fq * 4 + j) * DM + 3072 + gi * 256 + e] = (bf16)(cvtpk(acc[m][n][j] * sc, 0.f) & 0xffffu); }
    __syncthreads();
}

__device__ __forceinline__ void d1_scores(f32x16& p0, f32x16& p1, const bf16x8 (&kf0)[8], const bf16x8 (&kf1)[8], const bf16* __restrict__ qp, int dq, const LAS float* brow, bool far) {
    bf16x8 q[8];
#pragma unroll
    for (int d0 = 0; d0 < 8; ++d0) q[d0] = ld8(qp + d0 * 16);
    p0 = f32x16{}; p1 = f32x16{};
#pragma unroll
    for (int d0 = 0; d0 < 8; ++d0) { p0 = __builtin_amdgcn_mfma_f32_32x32x16_bf16(kf0[d0], q[d0], p0, 0, 0, 0); p1 = __builtin_amdgcn_mfma_f32_32x32x16_bf16(kf1[d0], q[d0], p1, 0, 0, 0); }
    score_tile<0>(p0, p1, dq, brow, brow[127], far, true);
}
__device__ __forceinline__ void d1_unit(int u, const bf16* __restrict__ proj, const bf16* __restrict__ cK, unsigned* __restrict__ selo, LAS unsigned char* lds, const LAS float* biasL,
                                        int tid, int wid, int lane) {
    const int tt = 255 - (u >> 2), g = u & 3, t0 = tt * 32, r32 = lane & 31, hi = lane >> 5, tpos = t0 + r32;
    const int nkt = tt / 32 + 1, kb = wid * 64;
    LAS float* ex = (LAS float*)lds;
    LAS float* imp = (LAS float*)(lds + 16384);
    LAS float* scw = (LAS float*)(lds + 16384 + 65664 + 128) + wid * 128;
    const bool act = wid < nkt;
    bf16x8 kf0[8], kf1[8];
    { const bf16* kp = cK + ((size_t)g * 512 + (act ? kb : 0) + r32) * 128 + hi * 8;
#pragma unroll
      for (int d0 = 0; d0 < 8; ++d0) { kf0[d0] = ld8(kp + d0 * 16); kf1[d0] = ld8(kp + 32 * 128 + d0 * 16); } }
    const int dq = tpos - 31 - 16 * kb - 64 * hi;
    const bool far = (t0 - 31 - 16 * (kb + 63)) >= 127;
    const bf16* qbase = proj + (size_t)tpos * NINP + C_Q + (g * 6) * 128 + hi * 8;
    if (act) {
#pragma unroll 1
        for (int h = 0; h < 6; ++h) {
            f32x16 p0, p1; d1_scores(p0, p1, kf0, kf1, qbase + h * 128, dq, biasL + (g * 6 + h) * 128, far);
            float mx = p0[0];
#pragma unroll
            for (int r = 1; r < 16; ++r) mx = fmaxf(mx, p0[r]);
#pragma unroll
            for (int r = 0; r < 16; ++r) mx = fmaxf(mx, p1[r]);
            mx = fmaxf(half_max(mx), -1e30f);
            float sm = 0.f;
#pragma unroll
            for (int r = 0; r < 16; ++r) sm += __builtin_amdgcn_exp2f(p0[r] - mx) + __builtin_amdgcn_exp2f(p1[r] - mx);
            sm = half_sum(sm);
            if (hi == 0) { ex[((wid * 6 + h) * 32 + r32) * 2] = mx; ex[((wid * 6 + h) * 32 + r32) * 2 + 1] = sm; }
        }
    }
    __syncthreads();
    f32x16 ia0 = {}, ia1 = {};
    if (act) {
#pragma unroll 1
        for (int h = 0; h < 6; ++h) {
            float M = -1e30f;
            for (int w = 0; w < nkt; ++w) M = fmaxf(M, ex[((w * 6 + h) * 32 + r32) * 2]);
            float L = 0.f;
            for (int w = 0; w < nkt; ++w) L += ex[((w * 6 + h) * 32 + r32) * 2 + 1] * __builtin_amdgcn_exp2f(ex[((w * 6 + h) * 32 + r32) * 2] - M);
            const float inv = L > 0.f ? 1.f / L : 0.f;
            f32x16 p0, p1; d1_scores(p0, p1, kf0, kf1, qbase + h * 128, dq, biasL + (g * 6 + h) * 128, far);
#pragma unroll
            for (int r = 0; r < 16; ++r) { ia0[r] += __builtin_amdgcn_exp2f(p0[r] - M) * inv; ia1[r] += __builtin_amdgcn_exp2f(p1[r] - M) * inv; }
        }
    }
#pragma unroll
    for (int r = 0; r < 16; ++r) { imp[r32 * 513 + kb + crow(r, hi)] = ia0[r]; imp[r32 * 513 + kb + 32 + crow(r, hi)] = ia1[r]; }
    __syncthreads();
#pragma unroll 1
    for (int q = 0; q < 4; ++q) {
        const int tk = wid * 4 + q, t = t0 + tk, cur = t >> 6; const LAS float* ir = imp + tk * 513;
        float sv[2];
#pragma unroll
        for (int hf = 0; hf < 2; ++hf) { const int j = lane + 64 * hf;
            float s = (j > 0) ? ir[4 * j - 1] : 0.f; s += 2.f * ir[4 * j]; s += 2.f * ir[4 * j + 1]; s += 2.f * ir[4 * j + 2]; s += ir[4 * j + 3];
            const bool forced = (j == 0) || (cur - j >= 0 && cur - j < 2), future = j * 64 > t;
            sv[hf] = forced ? 1e9f : (future ? -1e9f : s); }
        scw[lane] = sv[0]; scw[lane + 64] = sv[1];
        LDS_WAIT();
        int ra = 0, rb = 0; const int ja = lane, jb = lane + 64;
#pragma unroll 4
        for (int k = 0; k < 128; k += 4) { const f32x4 v = *reinterpret_cast<const LAS f32x4*>(scw + k);
#pragma unroll
            for (int i = 0; i < 4; ++i) { ra += (v[i] > sv[0] || (v[i] == sv[0] && (k + i) < ja)) ? 1 : 0; rb += (v[i] > sv[1] || (v[i] == sv[1] && (k + i) < jb)) ? 1 : 0; } }
        const unsigned long long mA = __ballot(ra < 16), mB = __ballot(rb < 16);
        if (lane == 0) { u32x4 w = {(unsigned)mA, (unsigned)(mA >> 32), (unsigned)mB, (unsigned)(mB >> 32)}; *(u32x4*)(selo + ((size_t)g * S + t) * 4) = w; }
        LDS_WAIT();
    }
    __syncthreads();
}

__device__ __forceinline__ void d2_unit(int u, const bf16* __restrict__ proj, const unsigned char* ws, bf16* __restrict__ mix, float* __restrict__ scr, LAS unsigned char* lds,
                                        const LAS float* biasL, LAS float* al_all, int tid_in, int wid, int lane_in) {
    int tid = tid_in; asm volatile("" : "+v"(tid)); const int lane = tid & 63; (void)lane_in;
    const int ti = 63 - u / 12, hp = u % 12, g = hp / 3, head = hp * 2 + (wid >> 2);
    const int r32 = lane & 31, hi = lane >> 5, tq0 = ti * 128 + (wid & 3) * 32, tpos = tq0 + r32;
    const LAS float* brow = biasL + head * 128; const float b31 = brow[127];
    LAS float* al_l = al_all + wid * 64;
    bf16x8 qr[8];
    { const bf16* qp = proj + (size_t)tpos * NINP + C_Q + head * 128 + hi * 8;
#pragma unroll
      for (int d0 = 0; d0 < 8; ++d0) qr[d0] = ld8(qp + d0 * 16); }
    const bf16* gl = proj + (size_t)tpos * NINP + C_GL + head * 3;
    const u32x4 sel0 = {0u, 0u, 0u, 0u};
    float m_reg, l_reg; f32x16 o[4];
    { const int n_max = (ti * 128 + 96) >> 4, NT = (n_max >> 6) + 1;
      attn_branch<0>((const bf16*)(ws + WS_CK) + (size_t)g * 65536, (const bf16*)(ws + WS_CV) + (size_t)g * 65536, 128, 0, NT, lds, qr, tq0, tpos, brow, b31, sel0, m_reg, l_reg, o, al_l, tid, lane);
      const float g_cmp = sigmoidf_(bf2f(gl[0])); const float f = l_reg > 0.f ? g_cmp / l_reg : 0.f; if (hi == 0) al_l[r32] = f; LDS_WAIT();
      float* s_ = scr + lane; asm volatile("" : "+v"(s_));
#pragma unroll
      for (int r = 0; r < 16; ++r) { const float a = al_l[crow(r, hi)];
#pragma unroll
          for (int d = 0; d < 4; ++d) s_[(d * 16 + r) * 64] = o[d][r] * a; }
      LDS_WAIT(); }
    { const u32x4 selw = *(const u32x4*)((const unsigned*)(ws + WS_SEL) + ((size_t)g * S + tpos) * 4);
      attn_branch<1>(proj + C_KS + g * 128, proj + C_VS + g * 128, NINP, 0, 2 * ti + 2, lds, qr, tq0, tpos, brow, b31, selw, m_reg, l_reg, o, al_l, tid, lane);
      const float g_slc = sigmoidf_(bf2f(gl[1])); const float f = l_reg > 0.f ? g_slc / l_reg : 0.f; if (hi == 0) al_l[r32] = f; LDS_WAIT();
      float* s_ = scr + 4096 + lane; asm volatile("" : "+v"(s_));
#pragma unroll
      for (int r = 0; r < 16; ++r) { const float a = al_l[crow(r, hi)];
#pragma unroll
          for (int d = 0; d < 4; ++d) s_[(d * 16 + r) * 64] = o[d][r] * a; }
      LDS_WAIT(); }
    { const int jl = max(0, 2 * ti - 8);
      attn_branch<2>(proj + C_KW + g * 128, proj + C_VW + g * 128, NINP, jl, 2 * ti + 2, lds, qr, tq0, tpos, brow, b31, sel0, m_reg, l_reg, o, al_l, tid, lane);
      const float g_win = sigmoidf_(bf2f(gl[2])); const float f = l_reg > 0.f ? g_win / l_reg : 0.f; if (hi == 0) al_l[r32] = f; LDS_WAIT();
      const float* s_ = scr + lane; asm volatile("" : "+v"(s_));
#pragma unroll
      for (int r = 0; r < 16; ++r) { const float a = al_l[crow(r, hi)]; const int orow = tq0 + crow(r, hi);
#pragma unroll
          for (int d = 0; d < 4; ++d) { const float v = o[d][r] * a + s_[(d * 16 + r) * 64] + s_[4096 + (d * 16 + r) * 64];
              const float vn = __shfl_xor(v, 1);
              if ((r32 & 1) == 0) *(unsigned*)(mix + (size_t)orow * DM + head * 128 + d * 32 + r32) = cvtpk(v, vn); } }
      LDS_WAIT(); }
}

__device__ __forceinline__ void conv_item(int it, const bf16* __restrict__ U, const float* __restrict__ cw, const float* __restrict__ cb, bf16* __restrict__ act, int lane) {
    const int cbk = it % 22, ch = it / 22, cv = cbk * 64 + lane; if (cv >= DFF / 8) return;
    const int n = cv * 8, t0 = ch * 32;
    float wa[3][8], wb[3][8], ba[8], bb[8];
#pragma unroll
    for (int k = 0; k < 3; ++k) { const f32x4 a0 = *(const f32x4*)(cw + (size_t)k * DFF2 + n), a1 = *(const f32x4*)(cw + (size_t)k * DFF2 + n + 4), b0 = *(const f32x4*)(cw + (size_t)k * DFF2 + DFF + n), b1 = *(const f32x4*)(cw + (size_t)k * DFF2 + DFF + n + 4);
#pragma unroll
        for (int i = 0; i < 4; ++i) { wa[k][i] = a0[i]; wa[k][4 + i] = a1[i]; wb[k][i] = b0[i]; wb[k][4 + i] = b1[i]; } }
    { const f32x4 a0 = *(const f32x4*)(cb + n), a1 = *(const f32x4*)(cb + n + 4), b0 = *(const f32x4*)(cb + DFF + n), b1 = *(const f32x4*)(cb + DFF + n + 4);
#pragma unroll
      for (int i = 0; i < 4; ++i) { ba[i] = a0[i]; ba[4 + i] = a1[i]; bb[i] = b0[i]; bb[4 + i] = b1[i]; } }
    float a2[8], a1_[8], b2[8], b1_[8];
#pragma unroll
    for (int i = 0; i < 8; ++i) { a2[i] = 0.f; a1_[i] = 0.f; b2[i] = 0.f; b1_[i] = 0.f; }
    if (t0 > 0) { const bf16x8 xa2 = ld8(U + (size_t)(t0 - 2) * DFF2 + n), xa1 = ld8(U + (size_t)(t0 - 1) * DFF2 + n), xb2 = ld8(U + (size_t)(t0 - 2) * DFF2 + DFF + n), xb1 = ld8(U + (size_t)(t0 - 1) * DFF2 + DFF + n);
#pragma unroll
        for (int i = 0; i < 8; ++i) { a2[i] = bf2f((unsigned short)xa2[i]); a1_[i] = bf2f((unsigned short)xa1[i]); b2[i] = bf2f((unsigned short)xb2[i]); b1_[i] = bf2f((unsigned short)xb1[i]); } }
#pragma unroll 2
    for (int t = t0; t < t0 + 32; ++t) {
        const bf16x8 xa = ld8(U + (size_t)t * DFF2 + n), xb = ld8(U + (size_t)t * DFF2 + DFF + n);
        float r[8];
#pragma unroll
        for (int i = 0; i < 8; ++i) { const float ua = bf2f((unsigned short)xa[i]), ub = bf2f((unsigned short)xb[i]);
            const float a = ba[i] + wa[0][i] * a2[i] + wa[1][i] * a1_[i] + wa[2][i] * ua;
            const float b = bb[i] + wb[0][i] * b2[i] + wb[1][i] * b1_[i] + wb[2][i] * ub;
            r[i] = a * sigmoidf_(a) * b; a2[i] = a1_[i]; a1_[i] = ua; b2[i] = b1_[i]; b1_[i] = ub; }
        u32x4 w = {cvtpk(r[0], r[1]), cvtpk(r[2], r[3]), cvtpk(r[4], r[5]), cvtpk(r[6], r[7])};
        *(u32x4*)(act + (size_t)t * DFF + n) = w;
    }
}

constexpr int NPH = 11;
__global__ void __launch_bounds__(512) mk_fwd(Params P) {
    extern __shared__ __attribute__((aligned(16))) unsigned char lds_raw[];
    cg::grid_group grid = cg::this_grid();
    LAS unsigned char* lds = (LAS unsigned char*)lds_raw;
    const int tid = threadIdx.x, lane = tid & 63, wid = __builtin_amdgcn_readfirstlane(tid >> 6);
    const int G = gridDim.x, gw = blockIdx.x * 8 + wid, NGW = G * 8;
    unsigned char* ws = P.ws;
    LAS float* biasL = (LAS float*)(lds + LDS_BIAS); LAS float* al_all = (LAS float*)(lds + LDS_AL); volatile LAS unsigned* misc = (volatile LAS unsigned*)(lds + LDS_MISC);
    const int lo = P.ph_lo, hi_ph = P.ph_hi;
#ifndef ONLY_PH
#define ONLY_PH -1
#endif
#define IN(k) ((ONLY_PH < 0 || ONLY_PH == (k)) && lo <= (k) && (k) < hi_ph)
#define SEAM(k) do { if (IN(k) && IN((k) + 1)) grid.sync(); } while (0)
    for (int i = tid; i < 24 * 128; i += 512) { const int h = i >> 7, d = i & 127; int b;
        if (d < 16) b = d; else { b = 16; b += d >= 19; b += d >= 21; b += d >= 24; b += d >= 27; b += d >= 31; b += d >= 35; b += d >= 40; b += d >= 46; b += d >= 52; b += d >= 59; b += d >= 67; b += d >= 77; b += d >= 87; b += d >= 99; b += d >= 113; }
        biasL[i] = P.in[11][b * 24 + h] * LOG2E; }
    __syncthreads();
    bf16* HN = (bf16*)(ws + WS_HN); bf16* PROJ = (bf16*)(ws + WS_PROJ); bf16* MIX = (bf16*)(ws + WS_MIX); float* H1 = (float*)(ws + WS_H1);
    bf16* UB = (bf16*)(ws + WS_U); bf16* ACT = (bf16*)(ws + WS_ACT);

    if (IN(0)) {
        LAS float* scr = (LAS float*)(lds + wid * 16384);
        constexpr int I0 = 64 * 227, I1 = 64 * 128, I2 = 64 * 688, I3 = 172 * 128, I4 = 4 * 8, I5 = 64 * 4, I6 = 2 * 4;
        constexpr int NIT = I0 + I1 + I2 + I3 + 4 * I4 + 2 * I5 + 2 * I6;
        for (int it = gw; it < NIT; it += NGW) {
            int r = it;
            if (r < I0) { tr_item(P.in[2], 4096, NIN, (bf16*)(ws + WS_WIN_T), scr, r, lane); continue; } r -= I0;
            if (r < I1) { tr_item(P.in[12], 4096, 4096, (bf16*)(ws + WS_WOUT_T), scr, r, lane); continue; } r -= I1;
            if (r < I2) { tr_item(P.in[14], 4096, DFF2, (bf16*)(ws + WS_WUP_T), scr, r, lane); continue; } r -= I2;
            if (r < I3) { tr_item(P.in[17], DFF, 4096, (bf16*)(ws + WS_WDN_T), scr, r, lane); continue; } r -= I3;
            if (r < 4 * I4) { const int gi = r / I4; tr_item(P.in[3] + (size_t)gi * 65536, 256, 256, (bf16*)(ws + WS_PWT) + (size_t)gi * 65536, scr, r - gi * I4, lane); continue; } r -= 4 * I4;
            if (r < I5) { tr_item(P.in[6], 4096, 128, (bf16*)(ws + WS_W1KT), scr, r, lane); continue; } r -= I5;
            if (r < I5) { tr_item(P.in[9], 4096, 128, (bf16*)(ws + WS_W1VT), scr, r, lane); continue; } r -= I5;
            if (r < I6) { tr_item(P.in[7], 128, 128, (bf16*)(ws + WS_W2KT), scr, r, lane); continue; } r -= I6;
            tr_item(P.in[10], 128, 128, (bf16*)(ws + WS_W2VT), scr, r, lane);
        }
        { u32x4* z = (u32x4*)((bf16*)(ws + WS_WIN_T) + (size_t)NIN * 4096); const size_t nz = (size_t)(NINP - NIN) * 4096 * 2 / 16;
          for (size_t i = (size_t)blockIdx.x * 512 + tid; i < nz; i += (size_t)G * 512) z[i] = (u32x4){0u, 0u, 0u, 0u}; }
        for (int it = gw; it < 64; it += NGW) { const int which = it >> 5, r = it & 31; const float* pe = P.in[which ? 8 : 5]; const float* w1 = P.in[which ? 9 : 6];
            float s0 = 0.f, s1 = 0.f;
            for (int kk = r * 128; kk < r * 128 + 128; ++kk) { const float p = pe[kk]; s0 += p * w1[(size_t)kk * 128 + lane]; s1 += p * w1[(size_t)kk * 128 + 64 + lane]; }
            float* c1p = (float*)(ws + WS_C1P) + (which * 32 + r) * 128; c1p[lane] = s0; c1p[64 + lane] = s1; }
        for (int m = gw; m < S; m += NGW) rms_row_bf16(P.in[0] + (size_t)m * DM, P.in[1], HN + (size_t)m * DM, lane);
        __syncthreads();
    }
    SEAM(0);
    if (IN(1)) {
        pg8::Gemm g{HN, (const bf16*)(ws + WS_WIN_T), S, NINP, DM}; pg8::StaticOrder So; So.init(S, NINP, G, (int)blockIdx.x);
        pg8::EpiBf16<0> E{PROJ, NINP, nullptr, 0, 0};
        pg8::gemm_phase<pg8::EpiBf16<0>, pg8::StaticOrder>(lds, g, So, E, nullptr);
    }
    SEAM(1);
    if (IN(2)) {
        for (int u = blockIdx.x; u < 1024 + 512; u += G) {
            if (u < 1024) compress_naive(u, PROJ, P.in[5], P.in[6], P.in[7], P.in[8], P.in[9], P.in[10], ws, lds, tid);
            else pool_unit(u - 1024, PROJ, (const bf16*)(ws + WS_PWT), P.in[4], MIX, lds, tid, wid, lane);
        }
    }
    SEAM(2);
    if (IN(3)) {
        for (int u = blockIdx.x; u < 1024; u += G) d1_unit(u, PROJ, (const bf16*)(ws + WS_CK), (unsigned*)(ws + WS_SEL), lds, biasL, tid, wid, lane);
    }
    SEAM(3);
    if (IN(4)) {
        unsigned* ctr = (unsigned*)(ws + WS_CTL);
        float* scr = (float*)(ws + WS_SCR) + (size_t)gw * 8192;
        for (;;) {
            __syncthreads();
            if (tid == 0) misc[0] = atomicAdd(ctr, 1u);
            __syncthreads();
            const int u = (int)misc[0];
            if (u >= 768) break;
            d2_unit(u, PROJ, ws, MIX, scr, lds, biasL, al_all, tid, wid, lane);
        }
    }
    SEAM(4);
    if (IN(5)) {
        pg8::Gemm g{MIX, (const bf16*)(ws + WS_WOUT_T), S, DM, DM}; pg8::StaticOrder So; So.init(S, DM, G, (int)blockIdx.x);
        pg8::EpiF32Res E{H1, DM, P.in[0]};
        pg8::gemm_phase<pg8::EpiF32Res, pg8::StaticOrder>(lds, g, So, E, nullptr);
    }
    SEAM(5);
    if (IN(6)) { for (int m = gw; m < S; m += NGW) rms_row_bf16(H1 + (size_t)m * DM, P.in[13], HN + (size_t)m * DM, lane); }
    SEAM(6);
    if (IN(7)) {
        pg8::Gemm g{HN, (const bf16*)(ws + WS_WUP_T), S, DFF2, DM}; pg8::StaticOrder So; So.init(S, DFF2, G, (int)blockIdx.x);
        pg8::EpiBf16<0> E{UB, DFF2, nullptr, 0, 0};
        pg8::gemm_phase<pg8::EpiBf16<0>, pg8::StaticOrder>(lds, g, So, E, nullptr);
    }
    SEAM(7);
    if (IN(8)) { for (int it = gw; it < 256 * 22; it += NGW) conv_item(it, UB, P.in[15], P.in[16], ACT, lane); }
    SEAM(8);
    if (IN(9)) {
        pg8::Gemm g{ACT, (const bf16*)(ws + WS_WDN_T), S, DM, DFF}; pg8::StaticOrder So; So.init(S, DM, G, (int)blockIdx.x);
        pg8::EpiF32Res E{P.out, DM, H1};
        pg8::gemm_phase<pg8::EpiF32Res, pg8::StaticOrder>(lds, g, So, E, nullptr);
    }
    SEAM(9);
    if (IN(10)) { for (int m = gw; m < S; m += NGW) rms_row_f32(P.out + (size_t)m * DM, P.in[18], P.out + (size_t)m * DM, lane); }
#undef IN
#undef SEAM
}

#ifndef MK_MULTI
#define MK_MULTI 0
#endif
extern "C" void kernel_launch(void* const* d_in, const int* in_sizes, int n_in, void* d_out, int out_size, void* d_ws, size_t ws_size, hipStream_t stream) {
    static int grid = 0;
    if (grid == 0) {
        if (n_in != 19 || out_size != S * DM || ws_size < WS_END) { fprintf(stderr, "kernel_launch: unexpected shapes (n_in %d out %d ws %zu)\n", n_in, out_size, ws_size); grid = -1; return; }
        int dev = 0, cus = 0, per_cu = 0;
        (void)hipGetDevice(&dev); (void)hipDeviceGetAttribute(&cus, hipDeviceAttributeMultiprocessorCount, dev);
        if (hipFuncSetAttribute((const void*)mk_fwd, hipFuncAttributeMaxDynamicSharedMemorySize, LDS_BYTES) != hipSuccess) { fprintf(stderr, "kernel_launch: hipFuncSetAttribute failed\n"); grid = -1; return; }
        if (hipOccupancyMaxActiveBlocksPerMultiprocessor(&per_cu, (const void*)mk_fwd, 512, LDS_BYTES) != hipSuccess || per_cu < 1) { fprintf(stderr, "kernel_launch: occupancy query says %d\n", per_cu); per_cu = 1; }
        (void)hipGetLastError();
        grid = cus * 1;
        if (grid <= 0) grid = 256;
    }
    if (grid < 0) return;
    (void)hipMemsetAsync((char*)d_ws + WS_CTL, 0, CTL_BYTES, stream);
    Params p{};
    for (int i = 0; i < 19; ++i) p.in[i] = (const float*)d_in[i];
    p.out = (float*)d_out; p.ws = (unsigned char*)d_ws;
#if MK_MULTI
    for (int ph = 0; ph < NPH; ++ph) { p.ph_lo = ph; p.ph_hi = ph + 1; hipLaunchKernelGGL(mk_fwd, dim3(grid), dim3(512), LDS_BYTES, stream, p); }
#else
    p.ph_lo = 0; p.ph_hi = NPH;
    void* args[] = {&p};
    hipError_t e = hipLaunchCooperativeKernel((const void*)mk_fwd, dim3(grid), dim3(512), args, LDS_BYTES, stream);
    if (e != hipSuccess) fprintf(stderr, "kernel_launch: cooperative launch failed: %s (grid %d)\n", hipGetErrorString(e), grid);
#endif
}
```

```cpp
#include <hip/hip_runtime.h>
#include <hip/hip_cooperative_groups.h>
#include <cstdio>
#include <cstdint>
namespace cg = cooperative_groups;
namespace pg8 {
#define PG8_LAS __attribute__((address_space(3)))
typedef unsigned short bf16_t;
typedef short bf16x8 __attribute__((ext_vector_type(8)));
typedef float f32x4 __attribute__((ext_vector_type(4)));
typedef unsigned u32x4 __attribute__((ext_vector_type(4)));
constexpr int BM = 256, BK = 64, HALF = 128, HTB = HALF * BK * 2  , STAGE_BYTES = 8 * HTB, NXCD = 8, WGM = 8;

__host__ __device__ __forceinline__ int lds_byte(int r, int c) { const int st = (r >> 4) * 2 + (c >> 5), rr = r & 15, cc = c & 31, ob = rr * 64 + cc * 2; return st * 1024 + (ob ^ (((ob >> 9) & 1) << 5)); }
__host__ __device__ __forceinline__ void stage_rc(int b, int& R, int& C) { const int st = b / 1024, sb = b % 1024, swz = sb ^ (((sb >> 9) & 1) << 5); R = (st >> 1) * 16 + swz / 64; C = (st & 1) * 32 + (swz % 64) / 2; }
__host__ __device__ __forceinline__ int perm32(int rho) { const int n = rho >> 4, i = rho & 15; return 8 * (i >> 2) + 4 * n + (i & 3); }

struct Unit { int pm, pn; };
struct Gemm { const bf16_t* A; const bf16_t* Bt; int M, N, K; };

struct StaticOrder {
    int nM, nN, nwg, G, c;
    __host__ __device__ void init(int M, int N, int G_, int c_) { nM = M / BM; nN = N / BM; nwg = nM * nN; G = G_; c = c_; }
    __host__ __device__ bool next(int i, Unit& u) const {
        const long L = (long)i * G + c; if (L >= nwg) return false;
        int wgid = (int)L; { const int q = nwg / NXCD, r = nwg % NXCD, xcd = wgid % NXCD, off = wgid / NXCD; wgid = (xcd < r ? xcd * (q + 1) : r * (q + 1) + (xcd - r) * q) + off; }
        const int nig = WGM * nN, gid = wgid / nig, fm = gid * WGM, gsz = (nM - fm) < WGM ? (nM - fm) : WGM;
        u.pm = fm + ((wgid % nig) % gsz); u.pn = (wgid % nig) / gsz; return true;
    }
    __device__ __forceinline__ void a_ready(const Unit&) const {}
    __device__ __forceinline__ void done(const Unit&) const {}
};
struct CountedOrder : StaticOrder {
    const unsigned* ready; unsigned need; unsigned* tmo;
    __device__ __forceinline__ void a_ready(const Unit& u) const {
        if (threadIdx.x < 64) {
            const unsigned long long t0 = __builtin_amdgcn_s_memrealtime(); unsigned polls = 0;
            while ((unsigned)__builtin_amdgcn_readfirstlane(__hip_atomic_load(ready + 64 * u.pm, __ATOMIC_RELAXED, __HIP_MEMORY_SCOPE_AGENT)) < need) {
                if ((++polls & 255u) == 0u && __builtin_amdgcn_readfirstlane(__hip_atomic_load(tmo, __ATOMIC_RELAXED, __HIP_MEMORY_SCOPE_AGENT)) != 0u) break;
                if (__builtin_amdgcn_s_memrealtime() - t0 > 2000000ull) {
                    if (threadIdx.x == 0) { unsigned expect = 0u; __hip_atomic_compare_exchange_strong(tmo + 1, &expect, 0x600u | (unsigned)(u.pm & 0xff), __ATOMIC_RELAXED, __ATOMIC_RELAXED, __HIP_MEMORY_SCOPE_AGENT); __hip_atomic_store(tmo, 1u, __ATOMIC_RELAXED, __HIP_MEMORY_SCOPE_AGENT); }
                    break; }
                __builtin_amdgcn_s_sleep(2); }
            __builtin_amdgcn_fence(__ATOMIC_ACQUIRE, "agent");
            asm volatile("s_waitcnt vmcnt(0)" ::: "memory");
        }
#if !defined(BROKEN_HOOK_NO_BARRIER)
        asm volatile("" ::: "memory"); __builtin_amdgcn_s_barrier(); asm volatile("" ::: "memory");
#endif
    }
};

__device__ __forceinline__ unsigned cvt_pk_bf16(float lo, float hi) { unsigned r; asm volatile("v_cvt_pk_bf16_f32 %0, %1, %2" : "=v"(r) : "v"(lo), "v"(hi)); return r; }
typedef float f32x2 __attribute__((ext_vector_type(2)));
__device__ __forceinline__ f32x2 gelu_pk(f32x2 v) {
    const f32x2 av = __builtin_elementwise_abs(v), d = av * 0.2316418882f + 1.0f;
    f32x2 t; t.x = __builtin_amdgcn_rcpf(d.x); t.y = __builtin_amdgcn_rcpf(d.y);
    f32x2 q = t * 0.5307027145f + (-0.7265760135f); q = q * t + 0.7107068705f; q = q * t + (-0.142248368f); q = q * t + 0.127414796f; q = q * t;
    const f32x2 s = (v * v) * (-0.72134752044f);
    f32x2 e; e.x = __builtin_amdgcn_exp2f(s.x); e.y = __builtin_amdgcn_exp2f(s.y);
    const f32x2 m = v * (q * e), r = v - m;
    f32x2 o; o.x = v.x < 0.f ? m.x : r.x; o.y = v.y < 0.f ? m.y : r.y; return o;
}

struct EpiF32 {
    static constexpr bool PERM = false, AFTER_DRAIN = false;
    float* C; int ldc; const float* bias;
    __device__ __forceinline__ void operator()(const f32x4 (&acc)[2][2][4][2], const Unit& u, int wr, int wc, int fr, int fq) const {
        const int row0 = u.pm * BM + wr * 64 + fr, col0 = u.pn * BM + wc * 32 + 4 * fq;
        f32x4 bv[2][2];
#pragma unroll
        for (int bj = 0; bj < 2; ++bj)
#pragma unroll
            for (int n = 0; n < 2; ++n) bv[bj][n] = bias ? *(const f32x4*)(bias + col0 + bj * HALF + n * 16) : (f32x4){0.f, 0.f, 0.f, 0.f};
#pragma unroll
        for (int ai = 0; ai < 2; ++ai)
#pragma unroll
            for (int m = 0; m < 4; ++m) { float* rowp = C + (size_t)(row0 + ai * HALF + m * 16) * ldc + col0;
#pragma unroll
                for (int bj = 0; bj < 2; ++bj)
#pragma unroll
                    for (int n = 0; n < 2; ++n) *(f32x4*)(rowp + bj * HALF + n * 16) = acc[ai][bj][m][n] + bv[bj][n]; }
    }
};
template <int ACT  > struct EpiBf16 {
    static constexpr bool PERM = true, AFTER_DRAIN = false;
    bf16_t* O; int ldc; const float* bias; int split_cols; size_t split_stride;
    __device__ __forceinline__ void operator()(const f32x4 (&acc)[2][2][4][2], const Unit& u, int wr, int wc, int fr, int fq) const {
        const int row0 = u.pm * BM + wr * 64 + fr; int colt = u.pn * BM; bf16_t* base = O;
        if (split_cols) { const int t = colt / split_cols; base += (size_t)t * split_stride; colt -= t * split_cols; }
        const int col0 = colt + wc * 32 + 8 * fq, bcol0 = u.pn * BM + wc * 32 + 8 * fq;
        f32x4 bv[2][2];
#pragma unroll
        for (int bj = 0; bj < 2; ++bj)
#pragma unroll
            for (int n = 0; n < 2; ++n) bv[bj][n] = bias ? *(const f32x4*)(bias + bcol0 + bj * HALF + 4 * n) : (f32x4){0.f, 0.f, 0.f, 0.f};
#pragma unroll
        for (int ai = 0; ai < 2; ++ai)
#pragma unroll
            for (int m = 0; m < 4; ++m) { bf16_t* rowp = base + (size_t)(row0 + ai * HALF + m * 16) * ldc + col0;
#pragma unroll
                for (int bj = 0; bj < 2; ++bj) { f32x4 v0 = acc[ai][bj][m][0] + bv[bj][0], v1 = acc[ai][bj][m][1] + bv[bj][1];
                    if (ACT == 1) { f32x2 a = gelu_pk((f32x2){v0[0], v0[1]}), b = gelu_pk((f32x2){v0[2], v0[3]}), c = gelu_pk((f32x2){v1[0], v1[1]}), d = gelu_pk((f32x2){v1[2], v1[3]});
                        v0 = (f32x4){a.x, a.y, b.x, b.y}; v1 = (f32x4){c.x, c.y, d.x, d.y}; }
                    if (ACT == 2) {
#pragma unroll
                        for (int j = 0; j < 4; ++j) { v0[j] = 0.5f * v0[j] * (1.0f + erff(v0[j] * 0.70710678f)); v1[j] = 0.5f * v1[j] * (1.0f + erff(v1[j] * 0.70710678f)); } }
                    u32x4 w; w.x = cvt_pk_bf16(v0[0], v0[1]); w.y = cvt_pk_bf16(v0[2], v0[3]); w.z = cvt_pk_bf16(v1[0], v1[1]); w.w = cvt_pk_bf16(v1[2], v1[3]);
                    *(u32x4*)(rowp + bj * HALF) = w; } }
    }
};
struct EpiF32Res {
    static constexpr bool PERM = false, AFTER_DRAIN = false;
    float* C; int ldc; const float* res;
    __device__ __forceinline__ void operator()(const f32x4 (&acc)[2][2][4][2], const Unit& u, int wr, int wc, int fr, int fq) const {
        const int row0 = u.pm * BM + wr * 64 + fr, col0 = u.pn * BM + wc * 32 + 4 * fq;
#pragma unroll
        for (int ai = 0; ai < 2; ++ai)
#pragma unroll
            for (int m = 0; m < 4; ++m) { const size_t off = (size_t)(row0 + ai * HALF + m * 16) * ldc + col0;
#pragma unroll
                for (int bj = 0; bj < 2; ++bj)
#pragma unroll
                    for (int n = 0; n < 2; ++n) { const f32x4 rv = *(const f32x4*)(res + off + bj * HALF + n * 16); *(f32x4*)(C + off + bj * HALF + n * 16) = acc[ai][bj][m][n] + rv; } }
    }
};


struct EpiF32ResNorm {
    static constexpr bool PERM = false, AFTER_DRAIN = false;
    float* C; int ldc; const float* res; bf16_t* hb; float* rowss;
    __device__ __forceinline__ void operator()(const f32x4 (&acc)[2][2][4][2], const Unit& u, int wr, int wc, int fr, int fq) const {
        typedef unsigned u32x2_ __attribute__((ext_vector_type(2)));
        const int row0 = u.pm * BM + wr * 64 + fr, col0 = u.pn * BM + wc * 32 + 4 * fq;
#pragma unroll
        for (int ai = 0; ai < 2; ++ai)
#pragma unroll
            for (int m = 0; m < 4; ++m) { const int row = row0 + ai * HALF + m * 16; const size_t off = (size_t)row * ldc + col0; float ss = 0.f;
#pragma unroll
                for (int bj = 0; bj < 2; ++bj)
#pragma unroll
                    for (int n = 0; n < 2; ++n) { const f32x4 rv = __builtin_nontemporal_load((const f32x4*)(res + off + bj * HALF + n * 16)); const f32x4 v = acc[ai][bj][m][n] + rv;
                        ss += (v.x * v.x + v.y * v.y) + (v.z * v.z + v.w * v.w);
                        u32x2_ w; w.x = cvt_pk_bf16(v.x, v.y); w.y = cvt_pk_bf16(v.z, v.w); *(u32x2_*)(hb + off + bj * HALF + n * 16) = w; }
                ss += __shfl_xor(ss, 16); ss += __shfl_xor(ss, 32);
                if (fq == 0) (void)__hip_atomic_fetch_add(rowss + row, ss, __ATOMIC_RELAXED, __HIP_MEMORY_SCOPE_AGENT); }
    }
};

struct EpiBf16ResB {
    static constexpr bool PERM = false, AFTER_DRAIN = false;
    bf16_t* O; int ldc; const bf16_t* resb;
    __device__ __forceinline__ void operator()(const f32x4 (&acc)[2][2][4][2], const Unit& u, int wr, int wc, int fr, int fq) const {
        typedef unsigned u32x2_ __attribute__((ext_vector_type(2)));
        const int row0 = u.pm * BM + wr * 64 + fr, col0 = u.pn * BM + wc * 32 + 4 * fq;
#pragma unroll
        for (int ai = 0; ai < 2; ++ai)
#pragma unroll
            for (int m = 0; m < 4; ++m) { const size_t off = (size_t)(row0 + ai * HALF + m * 16) * ldc + col0;
#pragma unroll
                for (int bj = 0; bj < 2; ++bj)
#pragma unroll
                    for (int n = 0; n < 2; ++n) { const u32x2_ rb = *(const u32x2_*)(resb + off + bj * HALF + n * 16); const f32x4 a = acc[ai][bj][m][n];
                        const float v0 = a.x + __uint_as_float(rb.x << 16), v1 = a.y + __uint_as_float(rb.x & 0xffff0000u), v2 = a.z + __uint_as_float(rb.y << 16), v3 = a.w + __uint_as_float(rb.y & 0xffff0000u);
                        u32x2_ w; w.x = cvt_pk_bf16(v0, v1); w.y = cvt_pk_bf16(v2, v3); *(u32x2_*)(O + off + bj * HALF + n * 16) = w; } }
    }
};
struct EpiConv {
    static constexpr bool PERM = true, AFTER_DRAIN = false;
    bf16_t* act; bf16_t* halo; const float* cw; const float* cb; int dff; const float* rowss;
    template <int ROR, int SHR> static __device__ __forceinline__ float dpp_prev(float x, float p) {
        const int xi = __float_as_int(x), pi = __float_as_int(p);
        const int o = __builtin_amdgcn_update_dpp(0, pi, ROR, 0xF, 0xF, false);
        return __int_as_float(__builtin_amdgcn_update_dpp(o, xi, SHR, 0xF, 0xF, false)); }
    __device__ __forceinline__ void operator()(const f32x4 (&acc)[2][2][4][2], const Unit& u, int wr, int wc, int fr, int fq) const {
        const int dff2 = 2 * dff;
        float rr[2][4];
#pragma unroll
        for (int ai = 0; ai < 2; ++ai)
#pragma unroll
            for (int m = 0; m < 4; ++m) rr[ai][m] = rsqrtf(rowss[u.pm * BM + ai * HALF + wr * 64 + m * 16 + fr] * (1.f / 4096.f) + 1e-6f);
#pragma unroll
        for (int n = 0; n < 2; ++n) {
            const int ch0 = u.pn * 128 + wc * 32 + 8 * fq + 4 * n;
            f32x4 wa[3], wb[3];
#pragma unroll
            for (int k = 0; k < 3; ++k) { wa[k] = *(const f32x4*)(cw + (size_t)k * dff2 + ch0); wb[k] = *(const f32x4*)(cw + (size_t)k * dff2 + dff + ch0); }
            const f32x4 ba = *(const f32x4*)(cb + ch0), bb = *(const f32x4*)(cb + dff + ch0);
#pragma unroll
            for (int ai = 0; ai < 2; ++ai) {
                const int panel = u.pm * 4 + ai * 2 + wr; const int rowp = panel * 64 + fr;
                f32x4 pa = {0.f, 0.f, 0.f, 0.f}, pb = {0.f, 0.f, 0.f, 0.f};
#pragma unroll
                for (int m = 0; m < 4; ++m) {
                    const f32x4 xa = acc[ai][0][m][n] * rr[ai][m], xb = acc[ai][1][m][n] * rr[ai][m];
                    float o[4];
#pragma unroll
                    for (int j = 0; j < 4; ++j) {
                        const float xav = xa[j], pav = pa[j], xbv = xb[j], pbv = pb[j];
                        const float a1 = dpp_prev<0x121, 0x111>(xav, pav), a2 = dpp_prev<0x122, 0x112>(xav, pav), b1 = dpp_prev<0x121, 0x111>(xbv, pbv), b2 = dpp_prev<0x122, 0x112>(xbv, pbv);
                        const float ca = ba[j] + wa[0][j] * a2 + wa[1][j] * a1 + wa[2][j] * xa[j];
                        const float cbv = bb[j] + wb[0][j] * b2 + wb[1][j] * b1 + wb[2][j] * xb[j];
                        o[j] = ca * __builtin_amdgcn_rcpf(1.f + __builtin_amdgcn_exp2f(ca * -1.4426950408889634f)) * cbv;
                    }
                    typedef unsigned u32x2_ __attribute__((ext_vector_type(2)));
                    const int row = rowp + 16 * m;
                    if (m > 0 || fr >= 2) { u32x2_ w; w.x = cvt_pk_bf16(o[0], o[1]); w.y = cvt_pk_bf16(o[2], o[3]); *(u32x2_*)(act + (size_t)row * dff + ch0) = w; }
                    if (m == 0 && fr < 2) { bf16_t* hp = halo + ((size_t)panel * 4 + fr) * dff2 + ch0; u32x2_ w; w.x = cvt_pk_bf16(xa[0], xa[1]); w.y = cvt_pk_bf16(xa[2], xa[3]); *(u32x2_*)hp = w;
                        w.x = cvt_pk_bf16(xb[0], xb[1]); w.y = cvt_pk_bf16(xb[2], xb[3]); *(u32x2_*)(hp + dff) = w; }
                    if (m == 3 && fr >= 14) { bf16_t* hp = halo + ((size_t)panel * 4 + 2 + (fr - 14)) * dff2 + ch0; u32x2_ w; w.x = cvt_pk_bf16(xa[0], xa[1]); w.y = cvt_pk_bf16(xa[2], xa[3]); *(u32x2_*)hp = w;
                        w.x = cvt_pk_bf16(xb[0], xb[1]); w.y = cvt_pk_bf16(xb[2], xb[3]); *(u32x2_*)(hp + dff) = w; }
                    pa = xa; pb = xb;
                }
            }
        }
    }
};
template <class Epi, class Sched, bool ALIGN_EPI = false, bool SP2 = false>
__device__ __forceinline__ void gemm_phase(PG8_LAS unsigned char* lds, const Gemm g, const Sched& S, const Epi& E) {
    const int tid = threadIdx.x, wid = __builtin_amdgcn_readfirstlane(tid >> 6), lane = tid & 63, wr = wid >> 2, wc = wid & 3, fr = lane & 15, fq = lane >> 4;
    const int K = g.K, nt = K / BK;
    unsigned voffA[2], voffB[2];
#pragma unroll
    for (int i = 0; i < 2; ++i) { int R, C; stage_rc(tid * 16 + i * 8192, R, C); const int Rb = Epi::PERM ? ((R & ~31) + perm32(R & 31)) : R;
        voffA[i] = (unsigned)(R * K + C) * 2u; voffB[i] = (unsigned)(Rb * K + C) * 2u; }
    const size_t kstep = (size_t)(BK * 2);
    const size_t hstep = (size_t)HALF * K * 2;
    const size_t tstep = 2 * hstep;
    const unsigned ldsw = (unsigned)wid * 1024u;
    const int aoff = lds_byte(wr * 64 + fr, fq * 8), boff = lds_byte(wc * 32 + fr, fq * 8);
#define PG8_SA(b, h) (((b) * 2 + (h)) * HTB)
#define PG8_SB(b, h) ((4 + (b) * 2 + (h)) * HTB)
#define PG8_STAGE(bufoff, gbase, voff) do { _Pragma("unroll") for (int _i = 0; _i < 2; ++_i) \
        __builtin_amdgcn_global_load_lds((const unsigned*)((const char*)(gbase) + (voff)[_i]), (PG8_LAS unsigned*)(lds + (bufoff) + ldsw + _i * 8192), 16, 0, 0); } while (0)
#define PG8_LDA(dst, b, h) do { _Pragma("unroll") for (int m = 0; m < 4; ++m) _Pragma("unroll") for (int k = 0; k < 2; ++k) dst[m][k] = *(const PG8_LAS bf16x8*)(lds + PG8_SA(b, h) + aoff + m * 2048 + k * 1024); } while (0)
#define PG8_LDB(dst, b, h) do { _Pragma("unroll") for (int n = 0; n < 2; ++n) _Pragma("unroll") for (int k = 0; k < 2; ++k) dst[n][k] = *(const PG8_LAS bf16x8*)(lds + PG8_SB(b, h) + boff + n * 2048 + k * 1024); } while (0)
#define PG8_MMA(ai, bj, At, Bt) do { __builtin_amdgcn_s_setprio(1); _Pragma("unroll") for (int m = 0; m < 4; ++m) _Pragma("unroll") for (int n = 0; n < 2; ++n) _Pragma("unroll") for (int k = 0; k < 2; ++k) \
        acc[ai][bj][m][n] = __builtin_amdgcn_mfma_f32_16x16x32_bf16(Bt[n][k], At[m][k], acc[ai][bj][m][n], 0, 0, 0); __builtin_amdgcn_s_setprio(0); } while (0)
#define PG8_WAIT_V(n) asm volatile("s_waitcnt vmcnt(" #n ")" ::: "memory")
#define PG8_WAIT_L(n) asm volatile("s_waitcnt lgkmcnt(" #n ")" ::: "memory")
#define PG8_BAR __builtin_amdgcn_s_barrier()
#define PG8_SCHED __builtin_amdgcn_sched_barrier(0)
    Unit cur, nxt; int ui = 0;
    if (!S.next(0, cur)) return;
    f32x4 acc[2][2][4][2];
#pragma unroll
    for (int a = 0; a < 2; ++a)
#pragma unroll
        for (int b = 0; b < 2; ++b)
#pragma unroll
            for (int m = 0; m < 4; ++m)
#pragma unroll
                for (int n = 0; n < 2; ++n) acc[a][b][m][n] = (f32x4){0.f, 0.f, 0.f, 0.f};
    bf16x8 At[4][2], B0[2][2], B1[2][2];
    const char* cA = (const char*)g.A + (size_t)cur.pm * tstep; const char* cB = (const char*)g.Bt + (size_t)cur.pn * tstep;
    S.a_ready(cur);
    if constexpr (SP2) {
        PG8_STAGE(PG8_SB(0, 0), cB, voffB); PG8_STAGE(PG8_SB(0, 1), cB + hstep, voffB); PG8_STAGE(PG8_SA(0, 0), cA, voffA); PG8_STAGE(PG8_SA(0, 1), cA + hstep, voffA);
        if (wr == 1) PG8_BAR;
        PG8_WAIT_V(2); PG8_BAR;
        PG8_STAGE(PG8_SB(1, 0), cB + kstep, voffB); PG8_STAGE(PG8_SA(1, 0), cA + kstep, voffA); PG8_STAGE(PG8_SB(1, 1), cB + hstep + kstep, voffB);
        PG8_WAIT_V(6); PG8_BAR;
    } else {
        PG8_STAGE(PG8_SB(0, 0), cB, voffB); PG8_STAGE(PG8_SA(0, 0), cA, voffA); PG8_STAGE(PG8_SB(0, 1), cB + hstep, voffB); PG8_STAGE(PG8_SA(0, 1), cA + hstep, voffA);
        if (wr == 1) PG8_BAR;
        PG8_WAIT_V(4); PG8_BAR;
        PG8_STAGE(PG8_SB(1, 0), cB + kstep, voffB); PG8_STAGE(PG8_SA(1, 0), cA + kstep, voffA); PG8_STAGE(PG8_SB(1, 1), cB + hstep + kstep, voffB);
        PG8_WAIT_V(6); PG8_BAR;
    }
    for (;;) {
        const bool has_next = S.next(ui + 1, nxt);
        const char* nA = has_next ? (const char*)g.A + (size_t)nxt.pm * tstep : cA; const char* nB = has_next ? (const char*)g.Bt + (size_t)nxt.pn * tstep : cB;
        for (int t = 0; t < nt; t += 2) {
            const bool last = (t == nt - 2);
            const char* a1 = cA + (size_t)(t + 1) * kstep;
            const char* a2 = last ? nA : cA + (size_t)(t + 2) * kstep; const char* b2 = last ? nB : cB + (size_t)(t + 2) * kstep;
            const char* a3 = a2 + kstep; const char* b3 = b2 + kstep;
            if (last && has_next) S.a_ready(nxt);
            if constexpr (SP2) {
            PG8_LDB(B0, 0, 0); PG8_LDB(B1, 0, 1); PG8_SCHED; PG8_LDA(At, 0, 0); PG8_STAGE(PG8_SA(1, 1), a1 + hstep, voffA);
            PG8_WAIT_V(8); PG8_WAIT_L(0); PG8_BAR; PG8_MMA(0, 0, At, B0); PG8_MMA(0, 1, At, B1); PG8_BAR; PG8_SCHED;
            PG8_LDA(At, 0, 1); PG8_STAGE(PG8_SB(0, 0), b2, voffB); PG8_STAGE(PG8_SB(0, 1), b2 + hstep, voffB); PG8_STAGE(PG8_SA(0, 0), a2, voffA);
            PG8_WAIT_V(8); PG8_WAIT_L(0); PG8_BAR; PG8_MMA(1, 0, At, B0); PG8_MMA(1, 1, At, B1); PG8_BAR; PG8_SCHED;
            PG8_LDB(B0, 1, 0); PG8_LDB(B1, 1, 1); PG8_SCHED; PG8_LDA(At, 1, 0); PG8_STAGE(PG8_SA(0, 1), a2 + hstep, voffA);
            PG8_WAIT_V(8); PG8_WAIT_L(0); PG8_BAR; PG8_MMA(0, 0, At, B0); PG8_MMA(0, 1, At, B1); PG8_BAR; PG8_SCHED;
            PG8_LDA(At, 1, 1); PG8_STAGE(PG8_SB(1, 0), b3, voffB); PG8_STAGE(PG8_SB(1, 1), b3 + hstep, voffB); PG8_STAGE(PG8_SA(1, 0), a3, voffA);
            PG8_WAIT_V(8); PG8_WAIT_L(0); PG8_BAR; PG8_MMA(1, 0, At, B0); PG8_MMA(1, 1, At, B1); PG8_BAR; PG8_SCHED;
            } else {
            PG8_LDB(B0, 0, 0); PG8_SCHED; PG8_LDA(At, 0, 0); PG8_STAGE(PG8_SA(1, 1), a1 + hstep, voffA);
            PG8_WAIT_L(8); PG8_BAR; PG8_WAIT_L(0); PG8_MMA(0, 0, At, B0); PG8_BAR; PG8_SCHED;
            PG8_LDB(B1, 0, 1); PG8_STAGE(PG8_SB(0, 0), b2, voffB);
            PG8_BAR; PG8_WAIT_L(0); PG8_MMA(0, 1, At, B1); PG8_BAR;
            PG8_LDA(At, 0, 1); PG8_STAGE(PG8_SA(0, 0), a2, voffA);
            PG8_BAR; PG8_WAIT_L(0); PG8_MMA(1, 0, At, B0); PG8_BAR; PG8_SCHED;
            PG8_STAGE(PG8_SB(0, 1), b2 + hstep, voffB);
            PG8_WAIT_V(6); PG8_BAR; PG8_MMA(1, 1, At, B1); PG8_BAR;
            PG8_LDB(B0, 1, 0); PG8_SCHED; PG8_LDA(At, 1, 0); PG8_STAGE(PG8_SA(0, 1), a2 + hstep, voffA);
            PG8_WAIT_L(8); PG8_BAR; PG8_WAIT_L(0); PG8_MMA(0, 0, At, B0); PG8_BAR; PG8_SCHED;
            PG8_LDB(B1, 1, 1); PG8_STAGE(PG8_SB(1, 0), b3, voffB);
            PG8_BAR; PG8_WAIT_L(0); PG8_MMA(0, 1, At, B1); PG8_BAR;
            PG8_LDA(At, 1, 1); PG8_STAGE(PG8_SA(1, 0), a3, voffA);
            PG8_BAR; PG8_WAIT_L(0); PG8_MMA(1, 0, At, B0); PG8_BAR; PG8_SCHED;
            PG8_STAGE(PG8_SB(1, 1), b3 + hstep, voffB);
            PG8_WAIT_V(6); PG8_BAR; PG8_MMA(1, 1, At, B1); PG8_BAR;
            }
        }
        if constexpr (ALIGN_EPI) { if (wr == 0) PG8_BAR; }
        if constexpr (!Epi::AFTER_DRAIN) { E(acc, cur, wr, wc, fr, fq); S.done(cur); }
        if (!has_next) break;
#pragma unroll
        for (int a = 0; a < 2; ++a)
#pragma unroll
            for (int b = 0; b < 2; ++b)
#pragma unroll
                for (int m = 0; m < 4; ++m)
#pragma unroll
                    for (int n = 0; n < 2; ++n) acc[a][b][m][n] = (f32x4){0.f, 0.f, 0.f, 0.f};
        cur = nxt; cA = nA; cB = nB; ++ui;
        if constexpr (ALIGN_EPI) { if (wr == 1) PG8_BAR; }
    }
    PG8_WAIT_V(0);
    if constexpr (!ALIGN_EPI) { if (wr == 0) PG8_BAR; }
    PG8_BAR;
    if constexpr (Epi::AFTER_DRAIN) { E.fused(acc, cur, wr, wc, fr, fq, lds, wid, lane); S.done(cur); }
#undef PG8_SA
#undef PG8_SB
#undef PG8_STAGE
#undef PG8_LDA
#undef PG8_LDB
#undef PG8_MMA
#undef PG8_WAIT_V
#undef PG8_WAIT_L
#undef PG8_BAR
#undef PG8_SCHED
}

}
#define LAS __attribute__((address_space(3)))
typedef unsigned short bf16;
typedef short bf16x8 __attribute__((ext_vector_type(8)));
typedef short s16x4 __attribute__((ext_vector_type(4)));
typedef float f32x16 __attribute__((ext_vector_type(16)));
typedef float f32x4 __attribute__((ext_vector_type(4)));
typedef unsigned u32x4 __attribute__((ext_vector_type(4)));
typedef unsigned u32x2 __attribute__((ext_vector_type(2)));

constexpr int S = 8192, DM = 4096, NIN = 7240, NINP = 7424, DFF = 11008, DFF2 = 22016;
constexpr int C_Q = 1024, C_KC = 4096, C_VC = 4608, C_KS = 5120, C_VS = 5632, C_KW = 6144, C_VW = 6656, C_GL = 7168;
constexpr float LOG2E = 1.4426950408889634f;
constexpr float C2S = 0.08838834764831845f * 1.4426950408889634f;
constexpr float RMS_EPS = 1e-6f;

constexpr size_t MiB = 1u << 20;
constexpr size_t WS_CTL = 0, CTL_BYTES = 65536;
constexpr size_t WS_WIN_T = 1 * MiB;
constexpr size_t WS_WOUT_T = 59 * MiB;
constexpr size_t WS_WUP_T = 91 * MiB;
constexpr size_t WS_WDN_T = 263 * MiB;
constexpr size_t WS_SMALL = 349 * MiB;
constexpr size_t WS_PWT = WS_SMALL;
constexpr size_t WS_W1KT = WS_SMALL + 1 * MiB;
constexpr size_t WS_W1VT = WS_SMALL + 2 * MiB;
constexpr size_t WS_W2KT = WS_SMALL + 3 * MiB;
constexpr size_t WS_W2VT = WS_SMALL + 3 * MiB + 65536;
constexpr size_t WS_C1P = WS_SMALL + 3 * MiB + 131072;
constexpr size_t WS_CK = WS_SMALL + 4 * MiB;
constexpr size_t WS_CV = WS_SMALL + 5 * MiB;
constexpr size_t WS_SEL = WS_SMALL + 6 * MiB;
constexpr size_t WS_HN = 357 * MiB;
constexpr size_t WS_PROJ = 421 * MiB;
constexpr size_t WS_MIX = 537 * MiB;
constexpr size_t WS_ACT = WS_PROJ;
constexpr size_t WS_SCR = 601 * MiB;
constexpr size_t WS_H1 = 665 * MiB;
constexpr size_t WS_U = 793 * MiB;
constexpr size_t WS_END = 1137 * MiB;

constexpr int RING_BYTES = 131072;
constexpr int LDS_BIAS = RING_BYTES;
constexpr int LDS_AL = LDS_BIAS + 24 * 128 * 4;
constexpr int LDS_MISC = LDS_AL + 8 * 64 * 4;
constexpr int LDS_BYTES = 147456;
static_assert(LDS_MISC + 64 <= LDS_BYTES, "lds map");

struct Params { const float* in[19]; float* out; unsigned char* ws; int ph_lo, ph_hi; };

#define LDS_WAIT() asm volatile("s_waitcnt lgkmcnt(0)" ::: "memory")
__device__ __forceinline__ unsigned cvtpk(float lo, float hi) { unsigned r; asm volatile("v_cvt_pk_bf16_f32 %0, %1, %2" : "=v"(r) : "v"(lo), "v"(hi)); return r; }
__device__ __forceinline__ float bf2f(unsigned short b) { return __uint_as_float(((unsigned)b) << 16); }
__device__ __forceinline__ bf16x8 pack8(f32x4 a, f32x4 b) { u32x4 w = {cvtpk(a[0], a[1]), cvtpk(a[2], a[3]), cvtpk(b[0], b[1]), cvtpk(b[2], b[3])}; return __builtin_bit_cast(bf16x8, w); }
__device__ __forceinline__ bf16x8 ld8(const bf16* p) { return *reinterpret_cast<const bf16x8*>(p); }
__device__ __forceinline__ float wave_sum(float v) {
#pragma unroll
    for (int o = 1; o < 64; o <<= 1) v += __shfl_xor(v, o);
    return v;
}
__device__ __forceinline__ float sigmoidf_(float x) { return __builtin_amdgcn_rcpf(1.f + __builtin_amdgcn_exp2f(x * -1.4426950408889634f)); }

template <bool REMAP = false, bool NT = false>
__device__ __forceinline__ void tr_item(const float* __restrict__ W, int K, int N, bf16* __restrict__ WT, LAS float* scr, int item, int lane, const float* __restrict__ rs = nullptr) {
    const int nblk = (N + 31) >> 5, kb = item / nblk, nb = item - kb * nblk, k0 = 64 * kb, n0 = 32 * nb;
    const int nn = n0 + (lane & 31); const bool ok = nn < N;
    float tv[32];
#pragma unroll
    for (int i = 0; i < 32; ++i) { const int kk = 2 * i + (lane >> 5); tv[i] = ok ? __builtin_nontemporal_load(W + (size_t)(k0 + kk) * N + nn) : 0.f; }
    if (rs) {
#pragma unroll
        for (int i = 0; i < 32; ++i) tv[i] *= rs[k0 + 2 * i + (lane >> 5)]; }
#pragma unroll
    for (int i = 0; i < 32; ++i) { const int kk = 2 * i + (lane >> 5); scr[kk * 33 + (lane & 31)] = tv[i]; }
    LDS_WAIT(); asm volatile("" ::: "memory");
    const int c = lane & 7;
#pragma unroll
    for (int j = 0; j < 4; ++j) { const int n = (lane >> 3) + 8 * j; const LAS float* s = scr + (8 * c) * 33 + n;
        u32x4 o; o.x = cvtpk(s[0 * 33], s[1 * 33]); o.y = cvtpk(s[2 * 33], s[3 * 33]); o.z = cvtpk(s[4 * 33], s[5 * 33]); o.w = cvtpk(s[6 * 33], s[7 * 33]);
        const int nn_ = n0 + n; int no = nn_;
        if (REMAP) no = nn_ < DFF ? ((nn_ >> 7) * 256 + (nn_ & 127)) : (((nn_ - DFF) >> 7) * 256 + 128 + ((nn_ - DFF) & 127));
        if (nn_ < N) { u32x4* dp = (u32x4*)(WT + (size_t)no * K + k0 + 8 * c); if (NT) __builtin_nontemporal_store(o, dp); else *dp = o; } }
    LDS_WAIT(); asm volatile("" ::: "memory");
}
__device__ __forceinline__ void rms_row_bf16(const float* __restrict__ xrow, const float* __restrict__ g, bf16* __restrict__ orow, int lane) {
    const f32x4* xr = (const f32x4*)xrow + lane; f32x4 v[16]; float s = 0.f;
#pragma unroll
    for (int j = 0; j < 16; ++j) { v[j] = __builtin_nontemporal_load(xr + 64 * j); s += (v[j].x * v[j].x + v[j].y * v[j].y) + (v[j].z * v[j].z + v[j].w * v[j].w); }
    const float r = rsqrtf(wave_sum(s) * (1.f / DM) + RMS_EPS);
    const f32x4* gr = (const f32x4*)g + lane; u32x2* o8 = (u32x2*)orow + lane;
#pragma unroll
    for (int j = 0; j < 16; ++j) { const f32x4 gv = gr[64 * j]; u32x2 w; w.x = cvtpk(v[j].x * r * gv.x, v[j].y * r * gv.y); w.y = cvtpk(v[j].z * r * gv.z, v[j].w * r * gv.w); o8[64 * j] = w; }
}
__device__ __forceinline__ void rms_row_f32(const float* xrow, const float* __restrict__ g, float* orow, int lane) {
    const f32x4* xr = (const f32x4*)xrow + lane; f32x4 v[16]; float s = 0.f;
#pragma unroll
    for (int j = 0; j < 16; ++j) { v[j] = xr[64 * j]; s += (v[j].x * v[j].x + v[j].y * v[j].y) + (v[j].z * v[j].z + v[j].w * v[j].w); }
    const float r = rsqrtf(wave_sum(s) * (1.f / DM) + RMS_EPS);
    const f32x4* gr = (const f32x4*)g + lane; f32x4* o = (f32x4*)orow + lane;
#pragma unroll
    for (int j = 0; j < 16; ++j) { const f32x4 gv = gr[64 * j]; o[64 * j] = v[j] * r * gv; }
}


__device__ __forceinline__ void rms_row_b2f(const bf16* __restrict__ xrow, const float* __restrict__ g, float* __restrict__ orow, int lane) {
    const u32x4* xr = (const u32x4*)xrow + lane; u32x4 v[8]; float s = 0.f;
#pragma unroll
    for (int j = 0; j < 8; ++j) { v[j] = __builtin_nontemporal_load(xr + 64 * j);
        const float a0 = __uint_as_float(v[j].x << 16), a1 = __uint_as_float(v[j].x & 0xffff0000u), a2 = __uint_as_float(v[j].y << 16), a3 = __uint_as_float(v[j].y & 0xffff0000u);
        const float a4 = __uint_as_float(v[j].z << 16), a5 = __uint_as_float(v[j].z & 0xffff0000u), a6 = __uint_as_float(v[j].w << 16), a7 = __uint_as_float(v[j].w & 0xffff0000u);
        s += ((a0 * a0 + a1 * a1) + (a2 * a2 + a3 * a3)) + ((a4 * a4 + a5 * a5) + (a6 * a6 + a7 * a7)); }
    const float r = rsqrtf(wave_sum(s) * (1.f / DM) + RMS_EPS);
#pragma unroll
    for (int j = 0; j < 8; ++j) { const int c = (lane + 64 * j) * 8; const f32x4 g0 = *(const f32x4*)(g + c), g1 = *(const f32x4*)(g + c + 4);
        f32x4 o0, o1;
        o0.x = __uint_as_float(v[j].x << 16) * r * g0.x; o0.y = __uint_as_float(v[j].x & 0xffff0000u) * r * g0.y; o0.z = __uint_as_float(v[j].y << 16) * r * g0.z; o0.w = __uint_as_float(v[j].y & 0xffff0000u) * r * g0.w;
        o1.x = __uint_as_float(v[j].z << 16) * r * g1.x; o1.y = __uint_as_float(v[j].z & 0xffff0000u) * r * g1.y; o1.z = __uint_as_float(v[j].w << 16) * r * g1.z; o1.w = __uint_as_float(v[j].w & 0xffff0000u) * r * g1.w;
        __builtin_nontemporal_store(o0, (f32x4*)(orow + c)); __builtin_nontemporal_store(o1, (f32x4*)(orow + c + 4)); }
}
#define KSWZ(row, colB) ((row) * 256 + ((colB) ^ (((row) & 7) << 4)))
#define SBAR() __builtin_amdgcn_sched_barrier(0)
constexpr int SHM_V = 16384, SHM_K = 16384;
__device__ __forceinline__ int v_st(int k, int c) { const int kk = (k & ~0xC) | ((k & 4) << 1) | ((k & 8) >> 1); return ((kk >> 3) * 4 + (c >> 5)) * 512 + ((kk & 7) * 32 + (c & 31)) * 2; }
__device__ __forceinline__ int v_rd_base(int lane) { return ((lane & 3) << 3) | (((lane >> 2) & 3) << 6) | (((lane >> 4) & 1) << 5) | (((lane >> 5) & 1) << 8); }
constexpr int v_rd_off(int d0, int ks, int half) { return d0 * 512 + ks * 4096 + half * 2048; }
__device__ __forceinline__ int crow(int r, int hi) { return (r & 3) + 8 * (r >> 2) + 4 * hi; }

template <int MODE>
__device__ __forceinline__ void score_tile(f32x16& p0, f32x16& p1, int dq, const LAS float* brow, float b31, bool far, bool sel) {
    const float NEG = -__builtin_inff();
    if (far && MODE == 1) {
#pragma unroll
        for (int r = 0; r < 16; ++r) { p0[r] = sel ? fmaf(p0[r], C2S, b31) : NEG; p1[r] = sel ? fmaf(p1[r], C2S, b31) : NEG; }
    } else if (far) {
#pragma unroll
        for (int r = 0; r < 16; ++r) {
            const int c = (r & 3) + 8 * (r >> 2);
            const int d0 = (MODE == 0) ? dq - 16 * c : dq - c, d1 = (MODE == 0) ? d0 - 512 : d0 - 32;
            bool v0, v1;
            if (MODE == 0) { v0 = d0 >= 0; v1 = d1 >= 0; } else if (MODE == 1) { v0 = sel && d0 >= 0; v1 = sel && d1 >= 0; } else { v0 = (unsigned)d0 < 512u; v1 = (unsigned)d1 < 512u; }
            p0[r] = v0 ? fmaf(p0[r], C2S, b31) : NEG; p1[r] = v1 ? fmaf(p1[r], C2S, b31) : NEG;
        }
    } else {
#pragma unroll
        for (int r = 0; r < 16; ++r) {
            const int c = (r & 3) + 8 * (r >> 2);
            const int d0 = (MODE == 0) ? dq - 16 * c : dq - c, d1 = (MODE == 0) ? d0 - 512 : d0 - 32;
            bool v0, v1;
            if (MODE == 0) { v0 = d0 >= 0; v1 = d1 >= 0; } else if (MODE == 1) { v0 = sel && d0 >= 0; v1 = sel && d1 >= 0; } else { v0 = (unsigned)d0 < 512u; v1 = (unsigned)d1 < 512u; }
            const float bb0 = brow[min(max(d0, 0), 127)];
            p0[r] = v0 ? fmaf(p0[r], C2S, bb0) : NEG; (void)v1;
        }
        SBAR();
#pragma unroll
        for (int r = 0; r < 16; ++r) {
            const int c = (r & 3) + 8 * (r >> 2);
            const int d0 = (MODE == 0) ? dq - 16 * c : dq - c, d1 = (MODE == 0) ? d0 - 512 : d0 - 32;
            bool v1;
            if (MODE == 0) { v1 = d1 >= 0; } else if (MODE == 1) { v1 = sel && d1 >= 0; } else { v1 = (unsigned)d1 < 512u; }
            const float bb1 = brow[min(max(d1, 0), 127)];
            p1[r] = v1 ? fmaf(p1[r], C2S, bb1) : NEG;
        }
    }
}
__device__ __forceinline__ float half_max(float v) { auto rr = __builtin_amdgcn_permlane32_swap(__float_as_uint(v), __float_as_uint(v), false, false); return fmaxf(__uint_as_float(rr[0]), __uint_as_float(rr[1])); }
__device__ __forceinline__ float half_sum(float v) { auto rr = __builtin_amdgcn_permlane32_swap(__float_as_uint(v), __float_as_uint(v), false, false); return __uint_as_float(rr[0]) + __uint_as_float(rr[1]); }

__device__ __forceinline__ void pv_tile(f32x16 (&o)[4], int vb0, bf16x8 pa0, bf16x8 pa1, bf16x8 pa2, bf16x8 pa3) {
#define TRRD(dst, off) asm volatile("ds_read_b64_tr_b16 %0, %1 offset:%2" : "=&v"(dst) : "v"(vb0), "i"(off) : "memory")
#define PV_D0(d0) do { s16x4 l0, l1, l2, l3, h0, h1, h2, h3; constexpr int b_ = v_rd_off(d0, 0, 0); \
        TRRD(l0, b_); TRRD(h0, b_ + 2048); TRRD(l1, b_ + 4096); TRRD(h1, b_ + 6144); TRRD(l2, b_ + 8192); TRRD(h2, b_ + 10240); TRRD(l3, b_ + 12288); TRRD(h3, b_ + 14336); \
        asm volatile("s_waitcnt lgkmcnt(0)" ::: "memory"); SBAR(); \
        o[d0] = __builtin_amdgcn_mfma_f32_32x32x16_bf16(pa0, (bf16x8){l0[0], l0[1], l0[2], l0[3], h0[0], h0[1], h0[2], h0[3]}, o[d0], 0, 0, 0); \
        o[d0] = __builtin_amdgcn_mfma_f32_32x32x16_bf16(pa1, (bf16x8){l1[0], l1[1], l1[2], l1[3], h1[0], h1[1], h1[2], h1[3]}, o[d0], 0, 0, 0); \
        o[d0] = __builtin_amdgcn_mfma_f32_32x32x16_bf16(pa2, (bf16x8){l2[0], l2[1], l2[2], l2[3], h2[0], h2[1], h2[2], h2[3]}, o[d0], 0, 0, 0); \
        o[d0] = __builtin_amdgcn_mfma_f32_32x32x16_bf16(pa3, (bf16x8){l3[0], l3[1], l3[2], l3[3], h3[0], h3[1], h3[2], h3[3]}, o[d0], 0, 0, 0); } while (0)
    PV_D0(0); PV_D0(1); PV_D0(2); PV_D0(3);
#undef PV_D0
#undef TRRD
}

template <int MODE>
__device__ __forceinline__ void attn_tile(const LAS char* Kb, int vb0, const bf16x8 (&qr)[8], int r32, int hi, int dq, const LAS float* brow, float b31, bool far, bool sel,
                                          float& m_reg, float& l_reg, f32x16 (&o)[4], LAS float* al_l) {
    f32x16 p0 = {}, p1 = {};
    const LAS char* kbp[4];
#pragma unroll
    for (int dd = 0; dd < 4; ++dd) kbp[dd] = Kb + KSWZ(r32, (dd * 16 + hi * 8) * 2);
#pragma unroll
    for (int d0 = 0; d0 < 8; ++d0) { const LAS char* a = kbp[d0 & 3] + (d0 >> 2) * 128;
        const bf16x8 b0 = *reinterpret_cast<const LAS bf16x8*>(a), b1 = *reinterpret_cast<const LAS bf16x8*>(a + 32 * 256);
        p0 = __builtin_amdgcn_mfma_f32_32x32x16_bf16(b0, qr[d0], p0, 0, 0, 0);
        p1 = __builtin_amdgcn_mfma_f32_32x32x16_bf16(b1, qr[d0], p1, 0, 0, 0); }
    float mn, alpha, ps = 0.f;
    if (far && MODE != 2) {
        float rmax = p0[0];
#pragma unroll
        for (int r = 1; r < 16; ++r) rmax = fmaxf(rmax, p0[r]);
#pragma unroll
        for (int r = 0; r < 16; ++r) rmax = fmaxf(rmax, p1[r]);
        rmax = half_max(rmax);
        const float NEGI = -__builtin_inff();
        const float pmax = sel ? fmaf(rmax, C2S, b31) : NEGI;
        if (__builtin_expect(__all(pmax - m_reg <= 8.f), 1)) { mn = m_reg; alpha = 1.f; }
        else { mn = fmaxf(m_reg, pmax); alpha = __builtin_amdgcn_exp2f(m_reg - mn); m_reg = mn; }
        const float t = sel ? b31 - mn : NEGI;
#pragma unroll
        for (int r = 0; r < 16; ++r) { p0[r] = __builtin_amdgcn_exp2f(fmaf(p0[r], C2S, t)); ps += p0[r]; }
#pragma unroll
        for (int r = 0; r < 16; ++r) { p1[r] = __builtin_amdgcn_exp2f(fmaf(p1[r], C2S, t)); ps += p1[r]; }
    } else {
        score_tile<MODE>(p0, p1, dq, brow, b31, far, sel);
        float pmax = p0[0];
#pragma unroll
        for (int r = 1; r < 16; ++r) pmax = fmaxf(pmax, p0[r]);
#pragma unroll
        for (int r = 0; r < 16; ++r) pmax = fmaxf(pmax, p1[r]);
        pmax = half_max(pmax);
        if (__builtin_expect(__all(pmax - m_reg <= 8.f), 1)) { mn = m_reg; alpha = 1.f; }
        else { mn = fmaxf(m_reg, pmax); alpha = __builtin_amdgcn_exp2f(m_reg - mn); m_reg = mn; }
#pragma unroll
        for (int r = 0; r < 16; ++r) { p0[r] = __builtin_amdgcn_exp2f(p0[r] - mn); ps += p0[r]; }
#pragma unroll
        for (int r = 0; r < 16; ++r) { p1[r] = __builtin_amdgcn_exp2f(p1[r] - mn); ps += p1[r]; }
    }
    ps = half_sum(ps);
    l_reg = l_reg * alpha + ps;
    if (__any(alpha < 1.f)) { if (hi == 0) al_l[r32] = alpha; LDS_WAIT();
#pragma unroll
        for (int r = 0; r < 16; ++r) { const float a = al_l[crow(r, hi)];
#pragma unroll
            for (int d = 0; d < 4; ++d) o[d][r] *= a; }
        LDS_WAIT(); }
    bf16x8 pa0, pa1, pa2, pa3;
#define PK4(P, B_, OUT) do { unsigned a0 = cvtpk(P[B_+0], P[B_+1]), a1 = cvtpk(P[B_+2], P[B_+3]); \
        unsigned b0_ = cvtpk(P[B_+4], P[B_+5]), b1_ = cvtpk(P[B_+6], P[B_+7]); \
        auto r0 = __builtin_amdgcn_permlane32_swap(a0, b0_, false, false); auto r1 = __builtin_amdgcn_permlane32_swap(a1, b1_, false, false); \
        u32x4 w = {r0[0], r1[0], r0[1], r1[1]}; OUT = __builtin_bit_cast(bf16x8, w); } while (0)
    PK4(p0, 0, pa0); PK4(p0, 8, pa1); PK4(p1, 0, pa2); PK4(p1, 8, pa3);
#undef PK4
    pv_tile(o, vb0, pa0, pa1, pa2, pa3);
}

template <int MODE>
__device__ __forceinline__ void attn_branch(const bf16* __restrict__ Kp, const bf16* __restrict__ Vp, int stride, int j_lo, int j_hi, LAS unsigned char* lds,
                                            const bf16x8 (&qr)[8], int tq0, int tpos, const LAS float* brow, float b31, u32x4 selw,
                                            float& m_reg, float& l_reg, f32x16 (&o)[4], LAS float* al_l, int tid, int lane) {
    const int r32 = lane & 31, hi = lane >> 5, sr = tid >> 4, sc = (tid & 15) * 8;
    const int kws = KSWZ(sr, sc * 2), vst0 = v_st(sr, sc), vst1 = v_st(32 + sr, sc);
    m_reg = -1e30f; l_reg = 0.f;
#pragma unroll
    for (int d = 0; d < 4; ++d) o[d] = f32x16{};
    bf16x8 sk0, sk1, sv0, sv1;
#define BLOAD(j) do { const size_t r0_ = (size_t)((j) * 64 + sr) * stride + sc, r1_ = r0_ + (size_t)32 * stride; \
        sk0 = ld8(Kp + r0_); sk1 = ld8(Kp + r1_); sv0 = ld8(Vp + r0_); sv1 = ld8(Vp + r1_); } while (0)
    BLOAD(j_lo);
    for (int j = j_lo; j < j_hi; ++j) {
        const int buf = (j - j_lo) & 1;
        LAS char* Vb = (LAS char*)lds + buf * SHM_V; LAS char* Kb = (LAS char*)lds + 2 * SHM_V + buf * SHM_K;
        *reinterpret_cast<LAS bf16x8*>(Kb + kws) = sk0; *reinterpret_cast<LAS bf16x8*>(Kb + kws + 32 * 256) = sk1;
        *reinterpret_cast<LAS bf16x8*>(Vb + vst0) = sv0; *reinterpret_cast<LAS bf16x8*>(Vb + vst1) = sv1;
        __syncthreads();
        if (j + 1 < j_hi) BLOAD(j + 1);
        const int kb = j * 64;
        bool skip, far, sel = true; int dq;
        if (MODE == 0) { skip = 16 * kb > tq0; far = (tq0 - 31 - 16 * (kb + 63)) >= 127; dq = tpos - 31 - 16 * kb - 64 * hi; }
        else {
            far = (tq0 - (kb + 63)) >= 127; dq = tpos - kb - 4 * hi;
            if (MODE == 1) { const unsigned w = j < 32 ? selw.x : (j < 64 ? selw.y : (j < 96 ? selw.z : selw.w)); sel = (w >> (j & 31)) & 1u; skip = (kb > tq0 + 31) || !__any(sel); }
            else skip = (kb > tq0 + 31) || (kb + 63 < tq0 - 511);
        }
        if (!skip) attn_tile<MODE>(Kb, (int)(size_t)Vb + v_rd_base(lane), qr, r32, hi, dq, brow, b31, far, sel, m_reg, l_reg, o, al_l);
    }
    __syncthreads();
#undef BLOAD
}

__device__ __forceinline__ void compress_unit(int u, const bf16* __restrict__ proj, unsigned char* ws, LAS unsigned char* lds, int tid, int wid, int lane) {
    const int which = u >> 6, g = (u >> 4) & 3, nb = u & 15, fr = lane & 15, fq = lane >> 4, e0 = wid * 16;
    const bf16* src = proj + (which ? C_VC : C_KC) + g * 128;
    const bf16* w1t = (const bf16*)(ws + (which ? WS_W1VT : WS_W1KT));
    const bf16* w2t = (const bf16*)(ws + (which ? WS_W2VT : WS_W2KT));
    const float* c1p = (const float*)(ws + WS_C1P) + which * 32 * 128;
    bf16* outp = (bf16*)(ws + (which ? WS_CV : WS_CK)) + (size_t)g * 512 * 128;
    LAS float* c1s = (LAS float*)lds; LAS bf16* hs = (LAS bf16*)(lds + 1024);
    if (tid < 128) { float s = 0.f; for (int r = 0; r < 32; ++r) s += c1p[r * 128 + tid]; c1s[tid] = s; }
    __syncthreads();
    const int na = nb * 32 + fr, nb_ = na + 16;
    const bf16* a0p = src + (size_t)(16 * min(na, 510)) * NINP + fq * 8;
    const bf16* a1p = src + (size_t)(16 * min(nb_, 510)) * NINP + fq * 8;
    const bf16* bp = w1t + (size_t)(e0 + fr) * 4096 + fq * 8;
    f32x4 acc0 = {0.f, 0.f, 0.f, 0.f}, acc1 = {0.f, 0.f, 0.f, 0.f};
#pragma unroll 2
    for (int l = 0; l < 32; ++l) {
#pragma unroll
        for (int k4 = 0; k4 < 4; ++k4) {
            const bf16x8 A0 = ld8(a0p + (size_t)l * NINP + k4 * 32), A1 = ld8(a1p + (size_t)l * NINP + k4 * 32), B = ld8(bp + l * 128 + k4 * 32);
            acc0 = __builtin_amdgcn_mfma_f32_16x16x32_bf16(A0, B, acc0, 0, 0, 0);
            acc1 = __builtin_amdgcn_mfma_f32_16x16x32_bf16(A1, B, acc1, 0, 0, 0);
        }
    }
    const float cc = c1s[e0 + fr];
#pragma unroll
    for (int j = 0; j < 4; ++j) {
        float h0 = acc0[j] + cc, h1 = acc1[j] + cc; h0 = h0 * sigmoidf_(h0); h1 = h1 * sigmoidf_(h1);
        hs[(fq * 4 + j) * 136 + e0 + fr] = (bf16)(cvtpk(h0, 0.f) & 0xffffu); hs[(16 + fq * 4 + j) * 136 + e0 + fr] = (bf16)(cvtpk(h1, 0.f) & 0xffffu);
    }
    __syncthreads();
    f32x4 o0 = {0.f, 0.f, 0.f, 0.f}, o1 = {0.f, 0.f, 0.f, 0.f};
#pragma unroll
    for (int ks = 0; ks < 4; ++ks) {
        const bf16x8 A0 = *reinterpret_cast<const LAS bf16x8*>(hs + fr * 136 + ks * 32 + fq * 8), A1 = *reinterpret_cast<const LAS bf16x8*>(hs + (16 + fr) * 136 + ks * 32 + fq * 8);
        const bf16x8 B = ld8(w2t + (size_t)(e0 + fr) * 128 + ks * 32 + fq * 8);
        o0 = __builtin_amdgcn_mfma_f32_16x16x32_bf16(A0, B, o0, 0, 0, 0);
        o1 = __builtin_amdgcn_mfma_f32_16x16x32_bf16(A1, B, o1, 0, 0, 0);
    }
#pragma unroll
    for (int j = 0; j < 4; ++j) {
        const int n0 = nb * 32 + fq * 4 + j, n1 = n0 + 16;
        outp[(size_t)n0 * 128 + e0 + fr] = n0 < 511 ? (bf16)(cvtpk(o0[j], 0.f) & 0xffffu) : (bf16)0;
        outp[(size_t)n1 * 128 + e0 + fr] = n1 < 511 ? (bf16)(cvtpk(o1[j], 0.f) & 0xffffu) : (bf16)0;
    }
    __syncthreads();
}


__device__ __forceinline__ void compress_naive(int u4, const bf16* __restrict__ proj, const float* pek, const float* w1k, const float* w2k, const float* pev, const float* w1v, const float* w2v, unsigned char* ws, LAS unsigned char* lds, int tid) {
    const int which = u4 >> 9, g = (u4 >> 7) & 3, nq = u4 & 127, sub = tid >> 7, e = tid & 127, n = nq * 4 + sub;
    const float* pe = which ? pev : pek; const float* w1 = which ? w1v : w1k; const float* w2 = which ? w2v : w2k;
    const bf16* src = proj + (which ? C_VC : C_KC) + g * 128;
    bf16* outp = (bf16*)(ws + (which ? WS_CV : WS_CK)) + (size_t)g * 512 * 128;
    LAS float* hsn = (LAS float*)lds;
    float acc = 0.f;
    if (n < 511) for (int kk = 0; kk < 4096; ++kk) { const int l = kk >> 7, d = kk & 127; const float a = bf2f(src[(size_t)(16 * n + l) * NINP + d]) + pe[kk]; acc += a * w1[(size_t)kk * 128 + e]; }
    hsn[sub * 128 + e] = acc * sigmoidf_(acc);
    __syncthreads();
    float o = 0.f;
    for (int k = 0; k < 128; ++k) o += hsn[sub * 128 + k] * w2[k * 128 + e];
    outp[(size_t)n * 128 + e] = n < 511 ? (bf16)(cvtpk(o, 0.f) & 0xffffu) : (bf16)0;
    __syncthreads();
}


__device__ __forceinline__ void compress_v2(int u, const bf16* __restrict__ proj, const float* __restrict__ pek, const float* __restrict__ w1k, const float* __restrict__ w2k,
                                            const float* __restrict__ pev, const float* __restrict__ w1v, const float* __restrict__ w2v, unsigned char* ws, LAS unsigned char* lds, int tid) {
    const int which = u >> 7, g = (u >> 5) & 3, nq = u & 31, e = tid & 127, sub = tid >> 7;
    const float* pe = which ? pev : pek; const float* w1 = which ? w1v : w1k; const float* w2 = which ? w2v : w2k;
    const bf16* src = proj + (which ? C_VC : C_KC) + g * 128;
    bf16* outp = (bf16*)(ws + (which ? WS_CV : WS_CK)) + (size_t)g * 512 * 128;
    LAS float* As = (LAS float*)lds;
    const int srow = tid >> 5, sd4 = (tid & 31) * 4, sn = min(nq * 16 + srow, 510);
    const bf16* sp = src + (size_t)(16 * sn) * NINP + sd4;
    float acc[4] = {0.f, 0.f, 0.f, 0.f};
    u32x2 raw = *(const u32x2*)(sp); f32x4 pv = *(const f32x4*)(pe + sd4);
    for (int l = 0; l < 32; ++l) {
        LAS float* Ab = As + (l & 1) * 2048;
        { f32x4 a; a[0] = __uint_as_float(raw.x << 16) + pv[0]; a[1] = __uint_as_float(raw.x & 0xffff0000u) + pv[1]; a[2] = __uint_as_float(raw.y << 16) + pv[2]; a[3] = __uint_as_float(raw.y & 0xffff0000u) + pv[3];
          *reinterpret_cast<LAS f32x4*>(Ab + srow * 128 + sd4) = a; }
        __syncthreads();
        if (l + 1 < 32) { raw = *(const u32x2*)(sp + (size_t)(l + 1) * NINP); pv = *(const f32x4*)(pe + (l + 1) * 128 + sd4); }
        const float* wp = w1 + (size_t)(l * 128) * 128 + e; const LAS float* ar = Ab + sub * 4 * 128;
#pragma unroll 4
        for (int d4 = 0; d4 < 32; ++d4) {
            const float w0 = wp[(d4 * 4 + 0) * 128], w1_ = wp[(d4 * 4 + 1) * 128], w2_ = wp[(d4 * 4 + 2) * 128], w3 = wp[(d4 * 4 + 3) * 128];
#pragma unroll
            for (int r = 0; r < 4; ++r) { const f32x4 a = *reinterpret_cast<const LAS f32x4*>(ar + r * 128 + d4 * 4);
                acc[r] += a[0] * w0; acc[r] += a[1] * w1_; acc[r] += a[2] * w2_; acc[r] += a[3] * w3; }
        }
    }
    __syncthreads();
    LAS float* Hs = As;
#pragma unroll
    for (int r = 0; r < 4; ++r) Hs[(sub * 4 + r) * 128 + e] = acc[r] * sigmoidf_(acc[r]);
    __syncthreads();
    float o[4] = {0.f, 0.f, 0.f, 0.f};
#pragma unroll 4
    for (int k4 = 0; k4 < 32; ++k4) {
        const float w0 = w2[(k4 * 4 + 0) * 128 + e], w1_ = w2[(k4 * 4 + 1) * 128 + e], w2_ = w2[(k4 * 4 + 2) * 128 + e], w3 = w2[(k4 * 4 + 3) * 128 + e];
#pragma unroll
        for (int r = 0; r < 4; ++r) { const f32x4 h = *reinterpret_cast<const LAS f32x4*>(Hs + (sub * 4 + r) * 128 + k4 * 4);
            o[r] += h[0] * w0; o[r] += h[1] * w1_; o[r] += h[2] * w2_; o[r] += h[3] * w3; }
    }
#pragma unroll
    for (int r = 0; r < 4; ++r) { const int n = nq * 16 + sub * 4 + r; outp[(size_t)n * 128 + e] = n < 511 ? (bf16)(cvtpk(o[r], 0.f) & 0xffffu) : (bf16)0; }
    __syncthreads();
}


__device__ __forceinline__ void compress_v3(int u, const bf16* __restrict__ proj, const float* __restrict__ pek, const float* __restrict__ pev, unsigned char* ws, LAS unsigned char* lds, int tid, int wid, int lane) {
    const int which = u >> 7, g = (u >> 5) & 3, nq = u & 31, fr = lane & 15, fq = lane >> 4, e0 = wid * 16;
    const float* pe = which ? pev : pek;
    const bf16* src = proj + (which ? C_VC : C_KC) + g * 128;
    const bf16* w1t = (const bf16*)(ws + (which ? WS_W1VT : WS_W1KT));
    const bf16* w2t = (const bf16*)(ws + (which ? WS_W2VT : WS_W2KT));
    bf16* outp = (bf16*)(ws + (which ? WS_CV : WS_CK)) + (size_t)g * 512 * 128;
    LAS bf16* As = (LAS bf16*)lds;
    LAS bf16* hs = (LAS bf16*)(lds + 16384);
    const int srow = (tid >> 4) & 15, sch = tid & 15; const bool stager = tid < 256;
    const bf16* sp = src + (size_t)(16 * min(nq * 16 + srow, 510)) * NINP + sch * 8;
    const bf16* bp = w1t + (size_t)(e0 + fr) * 4096 + fq * 8;
    bf16x8 araw = {}; f32x4 pe0 = {0.f, 0.f, 0.f, 0.f}, pe1 = {0.f, 0.f, 0.f, 0.f};
    if (stager) { araw = ld8(sp); pe0 = *(const f32x4*)(pe + sch * 8); pe1 = *(const f32x4*)(pe + sch * 8 + 4); }
    bf16x8 Bc[4];
#pragma unroll
    for (int ks = 0; ks < 4; ++ks) Bc[ks] = ld8(bp + ks * 32);
    if (stager) { f32x4 a0, a1;
#pragma unroll
        for (int i = 0; i < 4; ++i) { a0[i] = bf2f((unsigned short)araw[i]) + pe0[i]; a1[i] = bf2f((unsigned short)araw[4 + i]) + pe1[i]; }
        *reinterpret_cast<LAS bf16x8*>(As + srow * 136 + sch * 8) = pack8(a0, a1); }
    f32x4 acc[4];
#pragma unroll
    for (int ks = 0; ks < 4; ++ks) acc[ks] = (f32x4){0.f, 0.f, 0.f, 0.f};
#pragma unroll 1
    for (int l = 0; l < 32; ++l) {
        __syncthreads();
        LAS bf16* Ab = As + (l & 1) * (16 * 136);
        bf16x8 Bn[4];
        if (l + 1 < 32) {
            if (stager) { araw = ld8(sp + (size_t)(l + 1) * NINP); pe0 = *(const f32x4*)(pe + (l + 1) * 128 + sch * 8); pe1 = *(const f32x4*)(pe + (l + 1) * 128 + sch * 8 + 4); }
#pragma unroll
            for (int ks = 0; ks < 4; ++ks) Bn[ks] = ld8(bp + (l + 1) * 128 + ks * 32);
        }
#pragma unroll
        for (int ks = 0; ks < 4; ++ks) { const bf16x8 A = *reinterpret_cast<const LAS bf16x8*>(Ab + fr * 136 + ks * 32 + fq * 8);
            acc[ks] = __builtin_amdgcn_mfma_f32_16x16x32_bf16(A, Bc[ks], acc[ks], 0, 0, 0); }
        asm volatile("s_nop 7\n\ts_nop 7" ::: "memory");
        if (l + 1 < 32) {
            if (stager) { f32x4 a0, a1;
#pragma unroll
                for (int i = 0; i < 4; ++i) { a0[i] = bf2f((unsigned short)araw[i]) + pe0[i]; a1[i] = bf2f((unsigned short)araw[4 + i]) + pe1[i]; }
                *reinterpret_cast<LAS bf16x8*>(As + ((l + 1) & 1) * (16 * 136) + srow * 136 + sch * 8) = pack8(a0, a1); }
#pragma unroll
            for (int ks = 0; ks < 4; ++ks) Bc[ks] = Bn[ks];
        }
    }
    const f32x4 accs = (acc[0] + acc[1]) + (acc[2] + acc[3]);
    { const float h0 = accs.x, h1 = accs.y, h2 = accs.z, h3 = accs.w;
      hs[(fq * 4 + 0) * 136 + e0 + fr] = (bf16)(cvtpk(h0 * sigmoidf_(h0), 0.f) & 0xffffu); hs[(fq * 4 + 1) * 136 + e0 + fr] = (bf16)(cvtpk(h1 * sigmoidf_(h1), 0.f) & 0xffffu);
      hs[(fq * 4 + 2) * 136 + e0 + fr] = (bf16)(cvtpk(h2 * sigmoidf_(h2), 0.f) & 0xffffu); hs[(fq * 4 + 3) * 136 + e0 + fr] = (bf16)(cvtpk(h3 * sigmoidf_(h3), 0.f) & 0xffffu); }
    __syncthreads();
    f32x4 o4[4];
#pragma unroll
    for (int ks = 0; ks < 4; ++ks) {
        const bf16x8 A = *reinterpret_cast<const LAS bf16x8*>(hs + fr * 136 + ks * 32 + fq * 8);
        const bf16x8 B = ld8(w2t + (size_t)(e0 + fr) * 128 + ks * 32 + fq * 8);
        o4[ks] = __builtin_amdgcn_mfma_f32_16x16x32_bf16(A, B, (f32x4){0.f, 0.f, 0.f, 0.f}, 0, 0, 0);
    }
    asm volatile("s_nop 7\n\ts_nop 7" ::: "memory");
    const f32x4 os = (o4[0] + o4[1]) + (o4[2] + o4[3]);
    { const int n = nq * 16 + fq * 4; bf16* op = outp + (size_t)n * 128 + e0 + fr;
      op[0] = n + 0 < 511 ? (bf16)(cvtpk(os.x, 0.f) & 0xffffu) : (bf16)0; op[128] = n + 1 < 511 ? (bf16)(cvtpk(os.y, 0.f) & 0xffffu) : (bf16)0;
      op[256] = n + 2 < 511 ? (bf16)(cvtpk(os.z, 0.f) & 0xffffu) : (bf16)0; op[384] = n + 3 < 511 ? (bf16)(cvtpk(os.w, 0.f) & 0xffffu) : (bf16)0; }
    __syncthreads();
}

__device__ __forceinline__ void pool_unit(int u, const bf16* __restrict__ proj, const bf16* __restrict__ pwt, const float* __restrict__ pscale, bf16* __restrict__ mix,
                                          LAS unsigned char* lds, int tid, int wid, int lane) {
    const int tt = u >> 2, gi = u & 3, w = 2 << gi, fr = lane & 15, fq = lane >> 4;
    LAS bf16* dA = (LAS bf16*)lds;
    { const int c8 = tid & 31, tr = tid >> 5; const bf16* up = proj + gi * 256 + c8 * 8; const int tb = tt * 64 + tr * 4;
      float acc[4][8]; bf16x8 own[4];
#pragma unroll
      for (int q = 0; q < 4; ++q) {
#pragma unroll
          for (int i = 0; i < 8; ++i) acc[q][i] = 0.f; }
#define POOL_LOAD(W_) do { _Pragma("unroll") for (int i_ = 0; i_ < (W_) + 3; ++i_) { const int s_ = tb + 3 - i_; \
          bf16x8 v_ = {}; if (s_ >= 0) v_ = ld8(up + (size_t)s_ * NINP); \
          _Pragma("unroll") for (int q = 0; q < 4; ++q) { if (i_ >= 3 - q && i_ < 3 - q + (W_)) { _Pragma("unroll") for (int e_ = 0; e_ < 8; ++e_) acc[q][e_] += bf2f((unsigned short)v_[e_]); } \
              if (i_ == 3 - q) own[q] = v_; } } } while (0)
      if (gi == 0) POOL_LOAD(2); else if (gi == 1) POOL_LOAD(4); else if (gi == 2) POOL_LOAD(8); else POOL_LOAD(16);
#undef POOL_LOAD
#pragma unroll
      for (int q = 0; q < 4; ++q) { const int t = tb + q, lo = max(t + 1 - w, 0);
          const float inv = 1.f / (float)(t + 1 - lo); f32x4 d0, d1;
#pragma unroll
          for (int i = 0; i < 4; ++i) { d0[i] = acc[q][i] * inv - bf2f((unsigned short)own[q][i]); d1[i] = acc[q][4 + i] * inv - bf2f((unsigned short)own[q][4 + i]); }
          *reinterpret_cast<LAS bf16x8*>(dA + (tr * 4 + q) * 264 + c8 * 8) = pack8(d0, d1); } }
    __syncthreads();
    f32x4 acc[4][2];
#pragma unroll
    for (int m = 0; m < 4; ++m)
#pragma unroll
        for (int n = 0; n < 2; ++n) acc[m][n] = (f32x4){0.f, 0.f, 0.f, 0.f};
    const bf16* bp = pwt + (size_t)gi * 65536 + (size_t)(wid * 32 + fr) * 256 + fq * 8;
#pragma unroll
    for (int ks = 0; ks < 8; ++ks) {
        const bf16x8 B0 = ld8(bp + ks * 32), B1 = ld8(bp + 16 * 256 + ks * 32);
#pragma unroll
        for (int m = 0; m < 4; ++m) { const bf16x8 A = *reinterpret_cast<const LAS bf16x8*>(dA + (m * 16 + fr) * 264 + ks * 32 + fq * 8);
            acc[m][0] = __builtin_amdgcn_mfma_f32_16x16x32_bf16(A, B0, acc[m][0], 0, 0, 0);
            acc[m][1] = __builtin_amdgcn_mfma_f32_16x16x32_bf16(A, B1, acc[m][1], 0, 0, 0); }
    }
#pragma unroll
    for (int n = 0; n < 2; ++n) { const int e = wid * 32 + n * 16 + fr; const float sc = pscale[gi * 256 + e];
#pragma unroll
        for (int m = 0; m < 4; ++m)
#pragma unroll
            for (int j = 0; j < 4; ++j) mix[(size_t)(tt * 64 + m * 16 + fq * 4 + j) * DM + 3072 + gi * 256 + e] = (bf16)(cvtpk(acc[m][n][j] * sc, 0.f) & 0xffffu); }
    __syncthreads();
}

__device__ __forceinline__ void d1_scores(f32x16& p0, f32x16& p1, const bf16x8 (&kf0)[8], const bf16x8 (&kf1)[8], const LAS char* qh, int r32, int hi, int dq, const LAS float* brow, bool far) {
    bf16x8 q[2]; const LAS char* qb[4];
#pragma unroll
    for (int dd = 0; dd < 4; ++dd) qb[dd] = qh + KSWZ(r32, (dd * 16 + hi * 8) * 2);
    p0 = f32x16{}; p1 = f32x16{};
#pragma unroll
    for (int hh = 0; hh < 4; ++hh) {
#pragma unroll
        for (int dd = 0; dd < 2; ++dd) q[dd] = *reinterpret_cast<const LAS bf16x8*>(qb[(hh & 1) * 2 + dd] + (hh >> 1) * 128);
#pragma unroll
        for (int dd = 0; dd < 2; ++dd) { const int d0 = (hh >> 1) * 4 + (hh & 1) * 2 + dd; p0 = __builtin_amdgcn_mfma_f32_32x32x16_bf16(kf0[d0], q[dd], p0, 0, 0, 0); p1 = __builtin_amdgcn_mfma_f32_32x32x16_bf16(kf1[d0], q[dd], p1, 0, 0, 0); }
        SBAR();
    }
    score_tile<0>(p0, p1, dq, brow, brow[127], far, true);
}
__device__ __forceinline__ void d1_unit(int u, const bf16* proj_in, const bf16* cK_in, unsigned* selo_in, LAS unsigned char* lds, const LAS float* biasL,
                                        int tid_in, int wid, int lane_in) {
    const bf16* proj = proj_in; const bf16* cK = cK_in; unsigned* selo = selo_in; asm volatile("" : "+s"(proj), "+s"(cK), "+s"(selo));
    int tid = tid_in; asm volatile("" : "+v"(tid)); const int lane = tid & 63; (void)lane_in;
    const int tt = 255 - (u >> 2), g = u & 3, t0 = tt * 32, r32 = lane & 31, hi = lane >> 5, tpos = t0 + r32;
    const int nkt = tt / 32 + 1, kb = wid * 64;
    LAS float* scw = (LAS float*)lds + wid * 128;
    LAS float* ex = (LAS float*)(lds + 4096);
    LAS float* imp = (LAS float*)(lds + 16384);
    LAS char* Qs = (LAS char*)lds + 81920;
    const bool act = wid < nkt;
    { const int tk = tid >> 4, ch = tid & 15; const bf16* qp = proj + (size_t)(t0 + tk) * NINP + C_Q + (g * 6) * 128 + ch * 8;
      bf16x8 qv[6];
#pragma unroll
      for (int h = 0; h < 6; ++h) qv[h] = ld8(qp + h * 128);
#pragma unroll
      for (int h = 0; h < 6; ++h) *reinterpret_cast<LAS bf16x8*>(Qs + h * 8192 + KSWZ(tk, ch * 16)) = qv[h]; }
    asm volatile("s_waitcnt vmcnt(0) lgkmcnt(0)" ::: "memory"); SBAR();
    bf16x8 kf0[8], kf1[8];
    { const bf16* kp = cK + ((size_t)g * 512 + (act ? kb : 0) + r32) * 128 + hi * 8;
#pragma unroll
      for (int d0 = 0; d0 < 8; ++d0) { kf0[d0] = ld8(kp + d0 * 16); kf1[d0] = ld8(kp + 32 * 128 + d0 * 16); } }
    const int dq = tpos - 31 - 16 * kb - 64 * hi;
    const bool far = (t0 - 31 - 16 * (kb + 63)) >= 127;
    __syncthreads();
    unsigned ep[6][16];
#pragma unroll
    for (int h = 0; h < 6; ++h) {
#pragma unroll
        for (int r = 0; r < 16; ++r) ep[h][r] = 0u; }
    if (act) {
#pragma unroll
        for (int h = 0; h < 6; ++h) {
            f32x16 p0, p1; d1_scores(p0, p1, kf0, kf1, Qs + h * 8192, r32, hi, dq, biasL + (g * 6 + h) * 128, far);
            float mx = p0[0];
#pragma unroll
            for (int r = 1; r < 16; ++r) mx = fmaxf(mx, p0[r]);
#pragma unroll
            for (int r = 0; r < 16; ++r) mx = fmaxf(mx, p1[r]);
            mx = fmaxf(half_max(mx), -1e30f);
            float sm = 0.f;
#pragma unroll
            for (int r = 0; r < 16; ++r) { const float e0 = __builtin_amdgcn_exp2f(p0[r] - mx), e1 = __builtin_amdgcn_exp2f(p1[r] - mx); sm += e0 + e1; ep[h][r] = cvtpk(e0, e1); }
            sm = half_sum(sm);
            if (hi == 0) { ex[((wid * 6 + h) * 32 + r32) * 2] = mx; ex[((wid * 6 + h) * 32 + r32) * 2 + 1] = sm; }
        }
    }
    __syncthreads();
    f32x16 ia0 = {}, ia1 = {};
    if (act) {
#pragma unroll
        for (int h = 0; h < 6; ++h) {
            float M = -1e30f;
            for (int w = 0; w < nkt; ++w) M = fmaxf(M, ex[((w * 6 + h) * 32 + r32) * 2]);
            float L = 0.f;
            for (int w = 0; w < nkt; ++w) L += ex[((w * 6 + h) * 32 + r32) * 2 + 1] * __builtin_amdgcn_exp2f(ex[((w * 6 + h) * 32 + r32) * 2] - M);
            const float c = L > 0.f ? __builtin_amdgcn_exp2f(ex[((wid * 6 + h) * 32 + r32) * 2] - M) / L : 0.f;
#pragma unroll
            for (int r = 0; r < 16; ++r) { ia0[r] += __uint_as_float(ep[h][r] << 16) * c; ia1[r] += __uint_as_float(ep[h][r] & 0xffff0000u) * c; }
        }
    }
#pragma unroll
    for (int r = 0; r < 16; ++r) { imp[r32 * 512 + ((kb + crow(r, hi)) ^ r32)] = ia0[r]; imp[r32 * 512 + ((kb + 32 + crow(r, hi)) ^ r32)] = ia1[r]; }
    __syncthreads();
#pragma unroll 1
    for (int q = 0; q < 4; ++q) {
        const int tk = wid * 4 + q, t = t0 + tk, cur = t >> 6; const LAS float* ir = imp + tk * 512;
        float sv[2]; bool fo[2], cd[2];
#pragma unroll
        for (int hf = 0; hf < 2; ++hf) { const int j = lane + 64 * hf;
            float s = (j > 0) ? ir[(4 * j - 1) ^ tk] : 0.f; s += 2.f * ir[(4 * j) ^ tk]; s += 2.f * ir[(4 * j + 1) ^ tk]; s += 2.f * ir[(4 * j + 2) ^ tk]; s += ir[(4 * j + 3) ^ tk];
            const bool forced = (j == 0) || (cur - j >= 0 && cur - j < 2), future = j * 64 > t;
            sv[hf] = s; fo[hf] = forced; cd[hf] = !forced && !future; }
        const int nforced = __popcll(__ballot(fo[0])) + __popcll(__ballot(fo[1]));
        const int ncand = __popcll(__ballot(cd[0])) + __popcll(__ballot(cd[1]));
        int want = 16 - nforced; bool selA = cd[0], selB = cd[1];
        if (ncand > want) {
            const unsigned kA = __float_as_uint(sv[0]), kB = __float_as_uint(sv[1]); bool aA = cd[0], aB = cd[1]; unsigned T = 0u;
#pragma unroll 1
            for (int bit = 30; bit >= 0; --bit) { const unsigned m = 1u << bit; const bool hA = aA && (kA & m), hB = aB && (kB & m);
                const int c = __popcll(__ballot(hA)) + __popcll(__ballot(hB));
                if (c >= want) { aA = hA; aB = hB; T |= m; } else { want -= c; aA = aA && !(kA & m); aB = aB && !(kB & m); } }
            selA = cd[0] && kA >= T; selB = cd[1] && kB >= T;
        }
        const int ra = (fo[0] || selA) ? 0 : 99, rb = (fo[1] || selB) ? 0 : 99;
        const unsigned long long mA = __ballot(ra < 16), mB = __ballot(rb < 16);
        if (lane == 0) { u32x4 w = {(unsigned)mA, (unsigned)(mA >> 32), (unsigned)mB, (unsigned)(mB >> 32)}; *(u32x4*)(selo + ((size_t)g * S + t) * 4) = w; }
        LDS_WAIT();
    }
    __syncthreads();
}

__device__ __forceinline__ void d2_unit(int u, const bf16* __restrict__ proj, const unsigned char* ws, bf16* __restrict__ mix, float* __restrict__ scr, LAS unsigned char* lds,
                                        const LAS float* biasL, LAS float* al_all, int tid_in, int wid, int lane_in) {
    int tid = tid_in; asm volatile("" : "+v"(tid)); const int lane = tid & 63; (void)lane_in;
    const int ti = 63 - u / 12, hp = u % 12, g = hp / 3, head = hp * 2 + (wid >> 2);
    const int r32 = lane & 31, hi = lane >> 5, tq0 = ti * 128 + (wid & 3) * 32, tpos = tq0 + r32;
    const LAS float* brow = biasL + head * 128; const float b31 = brow[127];
    LAS float* al_l = al_all + wid * 64;
    bf16x8 qr[8];
    { const bf16* qp = proj + (size_t)tpos * NINP + C_Q + head * 128 + hi * 8;
#pragma unroll
      for (int d0 = 0; d0 < 8; ++d0) qr[d0] = ld8(qp + d0 * 16); }
    const bf16* gl = proj + (size_t)tpos * NINP + C_GL + head * 3;
    const u32x4 sel0 = {0u, 0u, 0u, 0u};
    float m_reg, l_reg; f32x16 o[4];
    { const int n_max = (ti * 128 + 96) >> 4, NT = (n_max >> 6) + 1;
      attn_branch<0>((const bf16*)(ws + WS_CK) + (size_t)g * 65536, (const bf16*)(ws + WS_CV) + (size_t)g * 65536, 128, 0, NT, lds, qr, tq0, tpos, brow, b31, sel0, m_reg, l_reg, o, al_l, tid, lane);
      const float g_cmp = sigmoidf_(bf2f(gl[0])); const float f = l_reg > 0.f ? g_cmp / l_reg : 0.f; if (hi == 0) al_l[r32] = f; LDS_WAIT();
      float* s_ = scr + lane; asm volatile("" : "+v"(s_));
#pragma unroll
      for (int r = 0; r < 16; ++r) { const float a = al_l[crow(r, hi)];
#pragma unroll
          for (int d = 0; d < 4; ++d) s_[(d * 16 + r) * 64] = o[d][r] * a; }
      LDS_WAIT(); }
    { const u32x4 selw = *(const u32x4*)((const unsigned*)(ws + WS_SEL) + ((size_t)g * S + tpos) * 4);
      attn_branch<1>(proj + C_KS + g * 128, proj + C_VS + g * 128, NINP, 0, 2 * ti + 2, lds, qr, tq0, tpos, brow, b31, selw, m_reg, l_reg, o, al_l, tid, lane);
      const float g_slc = sigmoidf_(bf2f(gl[1])); const float f = l_reg > 0.f ? g_slc / l_reg : 0.f; if (hi == 0) al_l[r32] = f; LDS_WAIT();
      float* s_ = scr + 4096 + lane; asm volatile("" : "+v"(s_));
#pragma unroll
      for (int r = 0; r < 16; ++r) { const float a = al_l[crow(r, hi)];
#pragma unroll
          for (int d = 0; d < 4; ++d) s_[(d * 16 + r) * 64] = o[d][r] * a; }
      LDS_WAIT(); }
    { const int jl = max(0, 2 * ti - 8);
      attn_branch<2>(proj + C_KW + g * 128, proj + C_VW + g * 128, NINP, jl, 2 * ti + 2, lds, qr, tq0, tpos, brow, b31, sel0, m_reg, l_reg, o, al_l, tid, lane);
      const float g_win = sigmoidf_(bf2f(gl[2])); const float f = l_reg > 0.f ? g_win / l_reg : 0.f; if (hi == 0) al_l[r32] = f; LDS_WAIT();
      const float* s_ = scr + lane; asm volatile("" : "+v"(s_));
#pragma unroll
      for (int r = 0; r < 16; ++r) { const float a = al_l[crow(r, hi)]; const int orow = tq0 + crow(r, hi);
#pragma unroll
          for (int d = 0; d < 4; ++d) { const float v = o[d][r] * a + s_[(d * 16 + r) * 64] + s_[4096 + (d * 16 + r) * 64];
              const float vn = __shfl_xor(v, 1);
              if ((r32 & 1) == 0) *(unsigned*)(mix + (size_t)orow * DM + head * 128 + d * 32 + r32) = cvtpk(v, vn); } }
      LDS_WAIT(); }
}

__device__ __forceinline__ void conv_item(int it, const bf16* __restrict__ U, const float* __restrict__ cw, const float* __restrict__ cb, bf16* __restrict__ act, int lane) {
    const int cbk = it % 22, ch = it / 22, cv = cbk * 64 + lane; if (cv >= DFF / 8) return;
    const int n = cv * 8, t0 = ch * 32;
    float wa[3][8], wb[3][8], ba[8], bb[8];
#pragma unroll
    for (int k = 0; k < 3; ++k) { const f32x4 a0 = *(const f32x4*)(cw + (size_t)k * DFF2 + n), a1 = *(const f32x4*)(cw + (size_t)k * DFF2 + n + 4), b0 = *(const f32x4*)(cw + (size_t)k * DFF2 + DFF + n), b1 = *(const f32x4*)(cw + (size_t)k * DFF2 + DFF + n + 4);
#pragma unroll
        for (int i = 0; i < 4; ++i) { wa[k][i] = a0[i]; wa[k][4 + i] = a1[i]; wb[k][i] = b0[i]; wb[k][4 + i] = b1[i]; } }
    { const f32x4 a0 = *(const f32x4*)(cb + n), a1 = *(const f32x4*)(cb + n + 4), b0 = *(const f32x4*)(cb + DFF + n), b1 = *(const f32x4*)(cb + DFF + n + 4);
#pragma unroll
      for (int i = 0; i < 4; ++i) { ba[i] = a0[i]; ba[4 + i] = a1[i]; bb[i] = b0[i]; bb[4 + i] = b1[i]; } }
    float a2[8], a1_[8], b2[8], b1_[8];
#pragma unroll
    for (int i = 0; i < 8; ++i) { a2[i] = 0.f; a1_[i] = 0.f; b2[i] = 0.f; b1_[i] = 0.f; }
    if (t0 > 0) { const bf16x8 xa2 = ld8(U + (size_t)(t0 - 2) * DFF2 + n), xa1 = ld8(U + (size_t)(t0 - 1) * DFF2 + n), xb2 = ld8(U + (size_t)(t0 - 2) * DFF2 + DFF + n), xb1 = ld8(U + (size_t)(t0 - 1) * DFF2 + DFF + n);
#pragma unroll
        for (int i = 0; i < 8; ++i) { a2[i] = bf2f((unsigned short)xa2[i]); a1_[i] = bf2f((unsigned short)xa1[i]); b2[i] = bf2f((unsigned short)xb2[i]); b1_[i] = bf2f((unsigned short)xb1[i]); } }
#pragma unroll 8
    for (int t = t0; t < t0 + 32; ++t) {
        const bf16x8 xa = ld8(U + (size_t)t * DFF2 + n), xb = ld8(U + (size_t)t * DFF2 + DFF + n);
        float r[8];
#pragma unroll
        for (int i = 0; i < 8; ++i) { const float ua = bf2f((unsigned short)xa[i]), ub = bf2f((unsigned short)xb[i]);
            const float a = ba[i] + wa[0][i] * a2[i] + wa[1][i] * a1_[i] + wa[2][i] * ua;
            const float b = bb[i] + wb[0][i] * b2[i] + wb[1][i] * b1_[i] + wb[2][i] * ub;
            r[i] = a * sigmoidf_(a) * b; a2[i] = a1_[i]; a1_[i] = ua; b2[i] = b1_[i]; b1_[i] = ub; }
        u32x4 w = {cvtpk(r[0], r[1]), cvtpk(r[2], r[3]), cvtpk(r[4], r[5]), cvtpk(r[6], r[7])};
        *(u32x4*)(act + (size_t)t * DFF + n) = w;
    }
}


__device__ __forceinline__ void conv_fix_item(int it, const bf16* __restrict__ halo, const float* __restrict__ cw, const float* __restrict__ cb, bf16* __restrict__ act, int lane) {
    const int cbk = it % 22, pr = it / 22, panel = pr >> 1, r = pr & 1, cv = cbk * 64 + lane; if (cv >= DFF / 8) return;
    const int n = cv * 8, t = panel * 64 + r;
    const bf16* h0 = halo + ((size_t)panel * 4 + r) * DFF2 + n;
    const bf16* h1 = r ? halo + ((size_t)panel * 4 + 0) * DFF2 + n : halo + ((size_t)(panel - 1) * 4 + 3) * DFF2 + n;
    const bf16* h2 = r ? halo + ((size_t)(panel - 1) * 4 + 3) * DFF2 + n : halo + ((size_t)(panel - 1) * 4 + 2) * DFF2 + n;
    const bool v1 = r || panel > 0, v2 = panel > 0;
    bf16x8 z = {}; const bf16x8 ua = ld8(h0), ub = ld8(h0 + DFF), ua1 = v1 ? ld8(h1) : z, ub1 = v1 ? ld8(h1 + DFF) : z, ua2 = v2 ? ld8(h2) : z, ub2 = v2 ? ld8(h2 + DFF) : z;
    float o[8];
#pragma unroll
    for (int i = 0; i < 8; ++i) {
        const float a = cb[n + i] + cw[n + i] * bf2f((unsigned short)ua2[i]) + cw[DFF2 + n + i] * bf2f((unsigned short)ua1[i]) + cw[2 * DFF2 + n + i] * bf2f((unsigned short)ua[i]);
        const float b = cb[DFF + n + i] + cw[DFF + n + i] * bf2f((unsigned short)ub2[i]) + cw[DFF2 + DFF + n + i] * bf2f((unsigned short)ub1[i]) + cw[2 * DFF2 + DFF + n + i] * bf2f((unsigned short)ub[i]);
        o[i] = a * sigmoidf_(a) * b; }
    u32x4 w = {cvtpk(o[0], o[1]), cvtpk(o[2], o[3]), cvtpk(o[4], o[5]), cvtpk(o[6], o[7])};
    *(u32x4*)(act + (size_t)t * DFF + n) = w;
}
#define XB_TMO      128
#define XB_XCNT(j)  (256  + 64 * (j))
#define XB_XSUB(j)  (1280 + 64 * (j))
#define XB_XGEN(j)  (2304 + 64 * (j))
#define XB_TOP      3328
#define XB_TOPGEN   3392
#define XCD_BAR_WORDS 3456
#define XB_SPIN_CAP (1u << 18)

__device__ __forceinline__ unsigned xb_ld(unsigned* p)              { return __hip_atomic_load(p, __ATOMIC_RELAXED, __HIP_MEMORY_SCOPE_AGENT); }
__device__ __forceinline__ unsigned xb_add(unsigned* p, unsigned v) { return __hip_atomic_fetch_add(p, v, __ATOMIC_RELAXED, __HIP_MEMORY_SCOPE_AGENT); }
__device__ __forceinline__ unsigned xb_xcc_id() { return (unsigned)__builtin_amdgcn_s_getreg((3 << 11) | 20) & 0xFu; }
#define XB_SPIN(cond, bar) do { unsigned _sp = 0; while (cond) { __builtin_amdgcn_s_sleep(1); \
    if ((++_sp & 255u) == 0u) { if (xb_ld(&(bar)[XB_TMO])) break; if (_sp > XB_SPIN_CAP) { atomicAdd(&(bar)[XB_TMO], 1u); break; } } } } while (0)

struct XcdBarrier {
    unsigned* bar; unsigned x;
    volatile LAS unsigned* st;
};

__device__ __forceinline__ XcdBarrier xcd_barrier_post(unsigned* bar, volatile LAS unsigned* st) {
    XcdBarrier b; b.bar = bar; b.x = xb_xcc_id(); b.st = st;
    if (threadIdx.x == 0) (void)xb_add(&bar[XB_XCNT(b.x)], 1u);
    return b;
}
__device__ __forceinline__ void xcd_barrier_complete(unsigned* bar, unsigned x, unsigned& nloc, unsigned& nx) {
    const unsigned G = gridDim.x * gridDim.y * gridDim.z;
    unsigned sum, cnt, mine, sp = 0u;
    for (;;) {
        sum = 0u; cnt = 0u; mine = 0u;
#pragma unroll
        for (unsigned j = 0; j < 16; ++j) { const unsigned c = xb_ld(&bar[XB_XCNT(j)]); sum += c; cnt += (c > 0u) ? 1u : 0u; mine = (j == x) ? c : mine; }
        if (sum == G) break;
        __builtin_amdgcn_s_sleep(1);
        if ((++sp & 255u) == 0u) { if (xb_ld(&bar[XB_TMO])) break; if (sp > XB_SPIN_CAP) { atomicAdd(&bar[XB_TMO], 1u); break; } }
    }
    nloc = mine > 0u ? mine : 1u; nx = cnt > 0u ? cnt : 1u;
}

__device__ __forceinline__ void xcd_barrier(const XcdBarrier& b) {
    asm volatile("s_waitcnt vmcnt(0)" ::: "memory");
    __syncthreads();
    if (threadIdx.x == 0) {
        unsigned* bar = b.bar;
        __builtin_amdgcn_s_waitcnt(0);
        unsigned nloc = b.st[0], nx = b.st[1];
        if (nloc == 0u) { xcd_barrier_complete(bar, b.x, nloc, nx); b.st[0] = nloc; b.st[1] = nx; }
        const unsigned old = xb_add(&bar[XB_XSUB(b.x)], 1u);
        const unsigned gen = old / nloc;
        if (old + 1u == (gen + 1u) * nloc) {
            __builtin_amdgcn_fence(__ATOMIC_RELEASE, "agent");
            asm volatile("s_waitcnt vmcnt(0)" ::: "memory");
            const unsigned og = xb_add(&bar[XB_TOP], 1u);
            const unsigned tg = og / nx;
            if (og + 1u == (tg + 1u) * nx) xb_add(&bar[XB_TOPGEN], 1u);
            else XB_SPIN(xb_ld(&bar[XB_TOPGEN]) == tg, bar);
            __builtin_amdgcn_fence(__ATOMIC_ACQUIRE, "agent");
            xb_add(&bar[XB_XGEN(b.x)], 1u);
            asm volatile("s_waitcnt vmcnt(0)" ::: "memory");
        } else {
            XB_SPIN(xb_ld(&bar[XB_XGEN(b.x)]) == gen, bar);
            __builtin_amdgcn_fence(__ATOMIC_ACQUIRE, "agent");
            asm volatile("s_waitcnt vmcnt(0)" ::: "memory");
        }
    }
    __syncthreads();
}

constexpr int NPH = 11;
__global__ void __launch_bounds__(512) mk_fwd(Params P) {
    extern __shared__ __attribute__((aligned(16))) unsigned char lds_raw[];
    cg::grid_group grid = cg::this_grid();
    LAS unsigned char* lds = (LAS unsigned char*)lds_raw;
    const int tid = threadIdx.x, lane = tid & 63, wid = __builtin_amdgcn_readfirstlane(tid >> 6);
    const int G = gridDim.x, gw = blockIdx.x * 8 + wid, NGW = G * 8;
    unsigned char* ws = P.ws;
    LAS float* biasL = (LAS float*)(lds + LDS_BIAS); LAS float* al_all = (LAS float*)(lds + LDS_AL); volatile LAS unsigned* misc = (volatile LAS unsigned*)(lds + LDS_MISC);
    const int lo = P.ph_lo, hi_ph = P.ph_hi;
#ifndef ONLY_PH
#define ONLY_PH -1
#endif
#define IN(k) ((ONLY_PH < 0 || ONLY_PH == (k)) && lo <= (k) && (k) < hi_ph)
#define SEAM(k) do { if (IN(k) && IN((k) + 1)) xcd_barrier(xbar); } while (0)
    for (int i = tid; i < 24 * 128; i += 512) { const int h = i >> 7, d = i & 127; int b;
        if (d < 16) b = d; else { b = 16; b += d >= 19; b += d >= 21; b += d >= 24; b += d >= 27; b += d >= 31; b += d >= 35; b += d >= 40; b += d >= 46; b += d >= 52; b += d >= 59; b += d >= 67; b += d >= 77; b += d >= 87; b += d >= 99; b += d >= 113; }
        biasL[i] = P.in[11][b * 24 + h] * LOG2E; }
    __syncthreads();
    if (tid == 0) { misc[8] = 0u; misc[9] = 0u; }
    __syncthreads();
    const XcdBarrier xbar = xcd_barrier_post((unsigned*)(ws + WS_CTL) + 1024, misc + 8);
    if (P.ph_hi > 1000) grid.sync();
    bf16* HN = (bf16*)(ws + WS_HN); bf16* PROJ = (bf16*)(ws + WS_PROJ); bf16* MIX = (bf16*)(ws + WS_MIX); float* H1 = (float*)(ws + WS_H1);
    bf16* UB = (bf16*)(ws + WS_U); bf16* ACT = (bf16*)(ws + WS_ACT);

    if (IN(0)) {
        int tid_ = threadIdx.x; asm volatile("" : "+v"(tid_)); const int tid = tid_, lane = tid_ & 63;
        LAS float* scr = (LAS float*)(lds + wid * 16384);
        constexpr int I0 = 64 * 227, I1 = 0, I2 = 0, I3 = 0,     I4 = 4 * 8, I5 = 64 * 4, I6 = 2 * 4;
        constexpr int NIT = I0 + I1 + I2 + I3 + 4 * I4 + 2 * I5 + 2 * I6;
        for (int it = gw; it < NIT; it += NGW) {
            int r = it;
            if (r < I0) { tr_item(P.in[2], 4096, NIN, (bf16*)(ws + WS_WIN_T), scr, r, lane); continue; } r -= I0;
            if (r < I1) { tr_item(P.in[12], 4096, 4096, (bf16*)(ws + WS_WOUT_T), scr, r, lane); continue; } r -= I1;
            if (r < I2) { tr_item<true>(P.in[14], 4096, DFF2, (bf16*)(ws + WS_WUP_T), scr, r, lane, P.in[13]); continue; } r -= I2;
            if (r < I3) { tr_item(P.in[17], DFF, 4096, (bf16*)(ws + WS_WDN_T), scr, r + 19200, lane); continue; } r -= I3;
            if (r < 4 * I4) { const int gi = r / I4; tr_item(P.in[3] + (size_t)gi * 65536, 256, 256, (bf16*)(ws + WS_PWT) + (size_t)gi * 65536, scr, r - gi * I4, lane); continue; } r -= 4 * I4;
            if (r < I5) { tr_item(P.in[6], 4096, 128, (bf16*)(ws + WS_W1KT), scr, r, lane); continue; } r -= I5;
            if (r < I5) { tr_item(P.in[9], 4096, 128, (bf16*)(ws + WS_W1VT), scr, r, lane); continue; } r -= I5;
            if (r < I6) { tr_item(P.in[7], 128, 128, (bf16*)(ws + WS_W2KT), scr, r, lane); continue; } r -= I6;
            tr_item(P.in[10], 128, 128, (bf16*)(ws + WS_W2VT), scr, r, lane);
        }
        { u32x4* z = (u32x4*)((bf16*)(ws + WS_WIN_T) + (size_t)NIN * 4096); const size_t nz = (size_t)(NINP - NIN) * 4096 * 2 / 16;
          for (size_t i = (size_t)blockIdx.x * 512 + tid; i < nz; i += (size_t)G * 512) z[i] = (u32x4){0u, 0u, 0u, 0u}; }
        for (int m = gw; m < S; m += NGW) rms_row_bf16(P.in[0] + (size_t)m * DM, P.in[1], HN + (size_t)m * DM, lane);
        __syncthreads();
    }
    SEAM(0);
    if (IN(1)) {
        pg8::Gemm g{HN, (const bf16*)(ws + WS_WIN_T), S, NINP, DM}; pg8::StaticOrder So; So.init(S, NINP, G, (int)blockIdx.x);
        pg8::EpiBf16<0> E{PROJ, NINP, nullptr, 0, 0};
        pg8::gemm_phase<pg8::EpiBf16<0>, pg8::StaticOrder, true, true>(lds, g, So, E);
        if (G == 256 && blockIdx.x >= 160) {
            LAS float* scr = (LAS float*)(lds + wid * 16384);
            for (int it = ((int)blockIdx.x - 160) * 8 + wid; it < 11008; it += 96 * 8) tr_item<false, true>(P.in[17], DFF, 4096, (bf16*)(ws + WS_WDN_T), scr, it, lane);
            __syncthreads(); }
        else if (G != 256) { LAS float* scr = (LAS float*)(lds + wid * 16384); for (int it = gw; it < 11008; it += NGW) tr_item(P.in[17], DFF, 4096, (bf16*)(ws + WS_WDN_T), scr, it, lane); __syncthreads(); }
    }
    SEAM(1);
    if (IN(2)) {
        for (int u = blockIdx.x; u < 256; u += G) compress_v3(u, PROJ, P.in[5], P.in[8], ws, lds, tid, wid, lane);
    }
    SEAM(2);
    if (IN(3)) {
        int tid_ = threadIdx.x; asm volatile("" : "+v"(tid_)); const int tid = tid_, lane = tid_ & 63;
        for (int u = blockIdx.x; u < 1024; u += G) d1_unit(u, PROJ, (const bf16*)(ws + WS_CK), (unsigned*)(ws + WS_SEL), lds, biasL, tid, wid, lane);
    }
    SEAM(3);
    if (IN(4)) {
        int tid_ = threadIdx.x; asm volatile("" : "+v"(tid_)); const int tid = tid_, lane = tid_ & 63;
        unsigned* ctr = (unsigned*)(ws + WS_CTL);
        float* scr = (float*)(ws + WS_SCR) + (size_t)gw * 8192;
        for (;;) {
            __syncthreads();
            if (tid == 0) misc[0] = atomicAdd(ctr, 1u);
            __syncthreads();
            const int u = (int)misc[0];
            if (u >= 768 + 512 + 860) break;
            int v; bool conv;
            if (u < 2 * 860) { conv = u & 1; v = u >> 1; } else { conv = false; v = u - 860; }
            if (conv) {
                LAS float* tscr = (LAS float*)(lds + wid * 16384);
#pragma unroll 1
                for (int j = 0; j < 8; ++j) { int r = v * 64 + j * 8 + wid;
                    if (r < 44032) { tr_item<true, true>(P.in[14], 4096, DFF2, (bf16*)(ws + WS_WUP_T), tscr, r, lane, P.in[13]); continue; } r -= 44032;
                    if (r < 8192) { tr_item<false, true>(P.in[12], 4096, 4096, (bf16*)(ws + WS_WOUT_T), tscr, r, lane); continue; } r -= 8192;
                    tr_item<false, true>(P.in[17], DFF, 4096, (bf16*)(ws + WS_WDN_T), tscr, r + 19200, lane); }
                continue; }
            if (v >= 768) { pool_unit(v - 768, PROJ, (const bf16*)(ws + WS_PWT), P.in[4], MIX, lds, tid, wid, lane); continue; }
            d2_unit(v, PROJ, ws, MIX, scr, lds, biasL, al_all, tid, wid, lane);
        }
    }
    SEAM(4);
    if (IN(5)) {
        pg8::Gemm g{MIX, (const bf16*)(ws + WS_WOUT_T), S, DM, DM}; pg8::StaticOrder So; So.init(S, DM, G, (int)blockIdx.x);
        pg8::EpiF32ResNorm E{H1, DM, P.in[0], HN, (float*)(ws + WS_CTL + 32768)};
        pg8::gemm_phase<pg8::EpiF32ResNorm, pg8::StaticOrder, true, true>(lds, g, So, E);
    }
    SEAM(5);
    SEAM(6);
    if (IN(7)) {
        pg8::Gemm g{HN, (const bf16*)(ws + WS_WUP_T), S, DFF2, DM}; pg8::StaticOrder So; So.init(S, DFF2, G, (int)blockIdx.x);
        pg8::EpiConv E{ACT, UB, P.in[15], P.in[16], DFF, (const float*)(ws + WS_CTL + 32768)};
        pg8::gemm_phase<pg8::EpiConv, pg8::StaticOrder, true, true>(lds, g, So, E);
        if (G == 256 && blockIdx.x >= 192) {
            LAS float* scr = (LAS float*)(lds + wid * 16384);
            for (int it = 11008 + ((int)blockIdx.x - 192) * 8 + wid; it < 19200; it += 64 * 8) tr_item<false, true>(P.in[17], DFF, 4096, (bf16*)(ws + WS_WDN_T), scr, it, lane);
            __syncthreads(); }
        else if (G != 256) { LAS float* scr = (LAS float*)(lds + wid * 16384); for (int it = 11008 + gw; it < 19200; it += NGW) tr_item(P.in[17], DFF, 4096, (bf16*)(ws + WS_WDN_T), scr, it, lane); __syncthreads(); }
    }
    SEAM(7);
    if (IN(8)) { for (int it = gw; it < 256 * 22; it += NGW) conv_fix_item(it, UB, P.in[15], P.in[16], ACT, lane); }
    SEAM(8);
    if (IN(9)) {
        pg8::Gemm g{ACT, (const bf16*)(ws + WS_WDN_T), S, DM, DFF}; pg8::StaticOrder So; So.init(S, DM, G, (int)blockIdx.x);
        pg8::EpiBf16ResB E{(bf16*)H1, DM, HN};
        pg8::gemm_phase<pg8::EpiBf16ResB, pg8::StaticOrder, true, true>(lds, g, So, E);
    }
    SEAM(9);
    if (IN(10)) { for (int m = gw; m < S; m += NGW) rms_row_b2f((const bf16*)H1 + (size_t)m * DM, P.in[18], P.out + (size_t)m * DM, lane); }
#undef IN
#undef SEAM
}

#ifndef MK_MULTI
#define MK_MULTI 0
#endif
extern "C" void kernel_launch(void* const* d_in, const int* in_sizes, int n_in, void* d_out, int out_size, void* d_ws, size_t ws_size, hipStream_t stream) {
    static int grid = 0;
    if (grid == 0) {
        if (n_in != 19 || out_size != S * DM || ws_size < WS_END) { fprintf(stderr, "kernel_launch: unexpected shapes (n_in %d out %d ws %zu)\n", n_in, out_size, ws_size); grid = -1; return; }
        int dev = 0, cus = 0, per_cu = 0;
        (void)hipGetDevice(&dev); (void)hipDeviceGetAttribute(&cus, hipDeviceAttributeMultiprocessorCount, dev);
        if (hipFuncSetAttribute((const void*)mk_fwd, hipFuncAttributeMaxDynamicSharedMemorySize, LDS_BYTES) != hipSuccess) { fprintf(stderr, "kernel_launch: hipFuncSetAttribute failed\n"); grid = -1; return; }
        if (hipOccupancyMaxActiveBlocksPerMultiprocessor(&per_cu, (const void*)mk_fwd, 512, LDS_BYTES) != hipSuccess || per_cu < 1) { fprintf(stderr, "kernel_launch: occupancy query says %d\n", per_cu); per_cu = 1; }
        (void)hipGetLastError();
        grid = cus * 1;
        if (grid <= 0) grid = 256;
    }
    if (grid < 0) return;
    (void)hipMemsetAsync((char*)d_ws + WS_CTL, 0, CTL_BYTES, stream);
    Params p{};
    for (int i = 0; i < 19; ++i) p.in[i] = (const float*)d_in[i];
    p.out = (float*)d_out; p.ws = (unsigned char*)d_ws;
#if MK_MULTI
    for (int ph = 0; ph < NPH; ++ph) { p.ph_lo = ph; p.ph_hi = ph + 1; hipLaunchKernelGGL(mk_fwd, dim3(grid), dim3(512), LDS_BYTES, stream, p); }
#else
    p.ph_lo = 0; p.ph_hi = NPH;
    void* args[] = {&p};
    hipError_t e = hipLaunchCooperativeKernel((const void*)mk_fwd, dim3(grid), dim3(512), args, LDS_BYTES, stream);
    if (e != hipSuccess) fprintf(stderr, "kernel_launch: cooperative launch failed: %s (grid %d)\n", hipGetErrorString(e), grid);
#endif
}
```

```cpp
#include <hip/hip_runtime.h>
#include <hip/hip_cooperative_groups.h>
#include <cstdio>
#include <cstdint>
namespace cg = cooperative_groups;
namespace pg8 {
#define PG8_LAS __attribute__((address_space(3)))
typedef unsigned short bf16_t;
typedef short bf16x8 __attribute__((ext_vector_type(8)));
typedef float f32x4 __attribute__((ext_vector_type(4)));
typedef unsigned u32x4 __attribute__((ext_vector_type(4)));
constexpr int BM = 256, BK = 64, HALF = 128, HTB = HALF * BK * 2  , STAGE_BYTES = 8 * HTB, NXCD = 8, WGM = 8;

__host__ __device__ __forceinline__ int lds_byte(int r, int c) { const int st = (r >> 4) * 2 + (c >> 5), rr = r & 15, cc = c & 31, ob = rr * 64 + cc * 2; return st * 1024 + (ob ^ (((ob >> 9) & 1) << 5)); }
__host__ __device__ __forceinline__ void stage_rc(int b, int& R, int& C) { const int st = b / 1024, sb = b % 1024, swz = sb ^ (((sb >> 9) & 1) << 5); R = (st >> 1) * 16 + swz / 64; C = (st & 1) * 32 + (swz % 64) / 2; }
__host__ __device__ __forceinline__ int perm32(int rho) { const int n = rho >> 4, i = rho & 15; return 8 * (i >> 2) + 4 * n + (i & 3); }

struct Unit { int pm, pn; };
struct Gemm { const bf16_t* A; const bf16_t* Bt; int M, N, K; };

struct StaticOrder {
    int nM, nN, nwg, G, c;
    __host__ __device__ void init(int M, int N, int G_, int c_) { nM = M / BM; nN = N / BM; nwg = nM * nN; G = G_; c = c_; }
    __host__ __device__ bool next(int i, Unit& u) const {
        const long L = (long)i * G + c; if (L >= nwg) return false;
        int wgid = (int)L; { const int q = nwg / NXCD, r = nwg % NXCD, xcd = wgid % NXCD, off = wgid / NXCD; wgid = (xcd < r ? xcd * (q + 1) : r * (q + 1) + (xcd - r) * q) + off; }
        const int nig = WGM * nN, gid = wgid / nig, fm = gid * WGM, gsz = (nM - fm) < WGM ? (nM - fm) : WGM;
        u.pm = fm + ((wgid % nig) % gsz); u.pn = (wgid % nig) / gsz; return true;
    }
    __device__ __forceinline__ void a_ready(const Unit&) const {}
    __device__ __forceinline__ void done(const Unit&) const {}
};
struct CountedOrder : StaticOrder {
    const unsigned* ready; unsigned need; unsigned* tmo;
    __device__ __forceinline__ void a_ready(const Unit& u) const {
        if (threadIdx.x < 64) {
            const unsigned long long t0 = __builtin_amdgcn_s_memrealtime(); unsigned polls = 0;
            while ((unsigned)__builtin_amdgcn_readfirstlane(__hip_atomic_load(ready + 64 * u.pm, __ATOMIC_RELAXED, __HIP_MEMORY_SCOPE_AGENT)) < need) {
                if ((++polls & 255u) == 0u && __builtin_amdgcn_readfirstlane(__hip_atomic_load(tmo, __ATOMIC_RELAXED, __HIP_MEMORY_SCOPE_AGENT)) != 0u) break;
                if (__builtin_amdgcn_s_memrealtime() - t0 > 2000000ull) {
                    if (threadIdx.x == 0) { unsigned expect = 0u; __hip_atomic_compare_exchange_strong(tmo + 1, &expect, 0x600u | (unsigned)(u.pm & 0xff), __ATOMIC_RELAXED, __ATOMIC_RELAXED, __HIP_MEMORY_SCOPE_AGENT); __hip_atomic_store(tmo, 1u, __ATOMIC_RELAXED, __HIP_MEMORY_SCOPE_AGENT); }
                    break; }
                __builtin_amdgcn_s_sleep(2); }
            __builtin_amdgcn_fence(__ATOMIC_ACQUIRE, "agent");
            asm volatile("s_waitcnt vmcnt(0)" ::: "memory");
        }
#if !defined(BROKEN_HOOK_NO_BARRIER)
        asm volatile("" ::: "memory"); __builtin_amdgcn_s_barrier(); asm volatile("" ::: "memory");
#endif
    }
};

__device__ __forceinline__ unsigned cvt_pk_bf16(float lo, float hi) { unsigned r; asm volatile("v_cvt_pk_bf16_f32 %0, %1, %2" : "=v"(r) : "v"(lo), "v"(hi)); return r; }
typedef float f32x2 __attribute__((ext_vector_type(2)));
__device__ __forceinline__ f32x2 gelu_pk(f32x2 v) {
    const f32x2 av = __builtin_elementwise_abs(v), d = av * 0.2316418882f + 1.0f;
    f32x2 t; t.x = __builtin_amdgcn_rcpf(d.x); t.y = __builtin_amdgcn_rcpf(d.y);
    f32x2 q = t * 0.5307027145f + (-0.7265760135f); q = q * t + 0.7107068705f; q = q * t + (-0.142248368f); q = q * t + 0.127414796f; q = q * t;
    const f32x2 s = (v * v) * (-0.72134752044f);
    f32x2 e; e.x = __builtin_amdgcn_exp2f(s.x); e.y = __builtin_amdgcn_exp2f(s.y);
    const f32x2 m = v * (q * e), r = v - m;
    f32x2 o; o.x = v.x < 0.f ? m.x : r.x; o.y = v.y < 0.f ? m.y : r.y; return o;
}

struct EpiF32 {
    static constexpr bool PERM = false, AFTER_DRAIN = false;
    float* C; int ldc; const float* bias;
    __device__ __forceinline__ void operator()(const f32x4 (&acc)[2][2][4][2], const Unit& u, int wr, int wc, int fr, int fq) const {
        const int row0 = u.pm * BM + wr * 64 + fr, col0 = u.pn * BM + wc * 32 + 4 * fq;
        f32x4 bv[2][2];
#pragma unroll
        for (int bj = 0; bj < 2; ++bj)
#pragma unroll
            for (int n = 0; n < 2; ++n) bv[bj][n] = bias ? *(const f32x4*)(bias + col0 + bj * HALF + n * 16) : (f32x4){0.f, 0.f, 0.f, 0.f};
#pragma unroll
        for (int ai = 0; ai < 2; ++ai)
#pragma unroll
            for (int m = 0; m < 4; ++m) { float* rowp = C + (size_t)(row0 + ai * HALF + m * 16) * ldc + col0;
#pragma unroll
                for (int bj = 0; bj < 2; ++bj)
#pragma unroll
                    for (int n = 0; n < 2; ++n) *(f32x4*)(rowp + bj * HALF + n * 16) = acc[ai][bj][m][n] + bv[bj][n]; }
    }
};
template <int ACT  > struct EpiBf16 {
    static constexpr bool PERM = true, AFTER_DRAIN = false;
    bf16_t* O; int ldc; const float* bias; int split_cols; size_t split_stride;
    __device__ __forceinline__ void operator()(const f32x4 (&acc)[2][2][4][2], const Unit& u, int wr, int wc, int fr, int fq) const {
        const int row0 = u.pm * BM + wr * 64 + fr; int colt = u.pn * BM; bf16_t* base = O;
        if (split_cols) { const int t = colt / split_cols; base += (size_t)t * split_stride; colt -= t * split_cols; }
        const int col0 = colt + wc * 32 + 8 * fq, bcol0 = u.pn * BM + wc * 32 + 8 * fq;
        f32x4 bv[2][2];
#pragma unroll
        for (int bj = 0; bj < 2; ++bj)
#pragma unroll
            for (int n = 0; n < 2; ++n) bv[bj][n] = bias ? *(const f32x4*)(bias + bcol0 + bj * HALF + 4 * n) : (f32x4){0.f, 0.f, 0.f, 0.f};
#pragma unroll
        for (int ai = 0; ai < 2; ++ai)
#pragma unroll
            for (int m = 0; m < 4; ++m) { bf16_t* rowp = base + (size_t)(row0 + ai * HALF + m * 16) * ldc + col0;
#pragma unroll
                for (int bj = 0; bj < 2; ++bj) { f32x4 v0 = acc[ai][bj][m][0] + bv[bj][0], v1 = acc[ai][bj][m][1] + bv[bj][1];
                    if (ACT == 1) { f32x2 a = gelu_pk((f32x2){v0[0], v0[1]}), b = gelu_pk((f32x2){v0[2], v0[3]}), c = gelu_pk((f32x2){v1[0], v1[1]}), d = gelu_pk((f32x2){v1[2], v1[3]});
                        v0 = (f32x4){a.x, a.y, b.x, b.y}; v1 = (f32x4){c.x, c.y, d.x, d.y}; }
                    if (ACT == 2) {
#pragma unroll
                        for (int j = 0; j < 4; ++j) { v0[j] = 0.5f * v0[j] * (1.0f + erff(v0[j] * 0.70710678f)); v1[j] = 0.5f * v1[j] * (1.0f + erff(v1[j] * 0.70710678f)); } }
                    u32x4 w; w.x = cvt_pk_bf16(v0[0], v0[1]); w.y = cvt_pk_bf16(v0[2], v0[3]); w.z = cvt_pk_bf16(v1[0], v1[1]); w.w = cvt_pk_bf16(v1[2], v1[3]);
                    *(u32x4*)(rowp + bj * HALF) = w; } }
    }
};
struct EpiF32Res {
    static constexpr bool PERM = false, AFTER_DRAIN = false;
    float* C; int ldc; const float* res;
    __device__ __forceinline__ void operator()(const f32x4 (&acc)[2][2][4][2], const Unit& u, int wr, int wc, int fr, int fq) const {
        const int row0 = u.pm * BM + wr * 64 + fr, col0 = u.pn * BM + wc * 32 + 4 * fq;
#pragma unroll
        for (int ai = 0; ai < 2; ++ai)
#pragma unroll
            for (int m = 0; m < 4; ++m) { const size_t off = (size_t)(row0 + ai * HALF + m * 16) * ldc + col0;
#pragma unroll
                for (int bj = 0; bj < 2; ++bj)
#pragma unroll
                    for (int n = 0; n < 2; ++n) { const f32x4 rv = *(const f32x4*)(res + off + bj * HALF + n * 16); *(f32x4*)(C + off + bj * HALF + n * 16) = acc[ai][bj][m][n] + rv; } }
    }
};


struct EpiF32ResNorm {
    static constexpr bool PERM = false, AFTER_DRAIN = false;
    float* C; int ldc; const float* res; bf16_t* hb; float* rowss;
    __device__ __forceinline__ void operator()(const f32x4 (&acc)[2][2][4][2], const Unit& u, int wr, int wc, int fr, int fq) const {
        typedef unsigned u32x2_ __attribute__((ext_vector_type(2)));
        const int row0 = u.pm * BM + wr * 64 + fr, col0 = u.pn * BM + wc * 32 + 4 * fq;
#pragma unroll
        for (int ai = 0; ai < 2; ++ai)
#pragma unroll
            for (int m = 0; m < 4; ++m) { const int row = row0 + ai * HALF + m * 16; const size_t off = (size_t)row * ldc + col0; float ss = 0.f;
#pragma unroll
                for (int bj = 0; bj < 2; ++bj)
#pragma unroll
                    for (int n = 0; n < 2; ++n) { const f32x4 rv = *(const f32x4*)(res + off + bj * HALF + n * 16); const f32x4 v = acc[ai][bj][m][n] + rv;
                        ss += (v.x * v.x + v.y * v.y) + (v.z * v.z + v.w * v.w);
                        u32x2_ w; w.x = cvt_pk_bf16(v.x, v.y); w.y = cvt_pk_bf16(v.z, v.w); *(u32x2_*)(hb + off + bj * HALF + n * 16) = w; }
                ss += __shfl_xor(ss, 16); ss += __shfl_xor(ss, 32);
                if (fq == 0) (void)__hip_atomic_fetch_add(rowss + row, ss, __ATOMIC_RELAXED, __HIP_MEMORY_SCOPE_AGENT); }
    }
};

struct EpiBf16ResB {
    static constexpr bool PERM = false, AFTER_DRAIN = false;
    bf16_t* O; int ldc; const bf16_t* resb;
    __device__ __forceinline__ void operator()(const f32x4 (&acc)[2][2][4][2], const Unit& u, int wr, int wc, int fr, int fq) const {
        typedef unsigned u32x2_ __attribute__((ext_vector_type(2)));
        const int row0 = u.pm * BM + wr * 64 + fr, col0 = u.pn * BM + wc * 32 + 4 * fq;
#pragma unroll
        for (int ai = 0; ai < 2; ++ai)
#pragma unroll
            for (int m = 0; m < 4; ++m) { const size_t off = (size_t)(row0 + ai * HALF + m * 16) * ldc + col0;
#pragma unroll
                for (int bj = 0; bj < 2; ++bj)
#pragma unroll
                    for (int n = 0; n < 2; ++n) { const u32x2_ rb = *(const u32x2_*)(resb + off + bj * HALF + n * 16); const f32x4 a = acc[ai][bj][m][n];
                        const float v0 = a.x + __uint_as_float(rb.x << 16), v1 = a.y + __uint_as_float(rb.x & 0xffff0000u), v2 = a.z + __uint_as_float(rb.y << 16), v3 = a.w + __uint_as_float(rb.y & 0xffff0000u);
                        u32x2_ w; w.x = cvt_pk_bf16(v0, v1); w.y = cvt_pk_bf16(v2, v3); *(u32x2_*)(O + off + bj * HALF + n * 16) = w; } }
    }
};
struct EpiConv {
    static constexpr bool PERM = true, AFTER_DRAIN = false;
    bf16_t* act; bf16_t* halo; const float* cw; const float* cb; int dff; const float* rowss;
    template <int ROR, int SHR> static __device__ __forceinline__ float dpp_prev(float x, float p) {
        const int xi = __float_as_int(x), pi = __float_as_int(p);
        const int o = __builtin_amdgcn_update_dpp(0, pi, ROR, 0xF, 0xF, false);
        return __int_as_float(__builtin_amdgcn_update_dpp(o, xi, SHR, 0xF, 0xF, false)); }
    __device__ __forceinline__ void operator()(const f32x4 (&acc)[2][2][4][2], const Unit& u, int wr, int wc, int fr, int fq) const {
        const int dff2 = 2 * dff;
        float rr[2][4];
#pragma unroll
        for (int ai = 0; ai < 2; ++ai)
#pragma unroll
            for (int m = 0; m < 4; ++m) rr[ai][m] = rsqrtf(rowss[u.pm * BM + ai * HALF + wr * 64 + m * 16 + fr] * (1.f / 4096.f) + 1e-6f);
#pragma unroll
        for (int n = 0; n < 2; ++n) {
            const int ch0 = u.pn * 128 + wc * 32 + 8 * fq + 4 * n;
            f32x4 wa[3], wb[3];
#pragma unroll
            for (int k = 0; k < 3; ++k) { wa[k] = *(const f32x4*)(cw + (size_t)k * dff2 + ch0); wb[k] = *(const f32x4*)(cw + (size_t)k * dff2 + dff + ch0); }
            const f32x4 ba = *(const f32x4*)(cb + ch0), bb = *(const f32x4*)(cb + dff + ch0);
#pragma unroll
            for (int ai = 0; ai < 2; ++ai) {
                const int panel = u.pm * 4 + ai * 2 + wr; const int rowp = panel * 64 + fr;
                f32x4 pa = {0.f, 0.f, 0.f, 0.f}, pb = {0.f, 0.f, 0.f, 0.f};
#pragma unroll
                for (int m = 0; m < 4; ++m) {
                    const f32x4 xa = acc[ai][0][m][n] * rr[ai][m], xb = acc[ai][1][m][n] * rr[ai][m];
                    float o[4];
#pragma unroll
                    for (int j = 0; j < 4; ++j) {
                        const float xav = xa[j], pav = pa[j], xbv = xb[j], pbv = pb[j];
                        const float a1 = dpp_prev<0x121, 0x111>(xav, pav), a2 = dpp_prev<0x122, 0x112>(xav, pav), b1 = dpp_prev<0x121, 0x111>(xbv, pbv), b2 = dpp_prev<0x122, 0x112>(xbv, pbv);
                        const float ca = ba[j] + wa[0][j] * a2 + wa[1][j] * a1 + wa[2][j] * xa[j];
                        const float cbv = bb[j] + wb[0][j] * b2 + wb[1][j] * b1 + wb[2][j] * xb[j];
                        o[j] = ca * __builtin_amdgcn_rcpf(1.f + __builtin_amdgcn_exp2f(ca * -1.4426950408889634f)) * cbv;
                    }
                    typedef unsigned u32x2_ __attribute__((ext_vector_type(2)));
                    const int row = rowp + 16 * m;
                    if (m > 0 || fr >= 2) { u32x2_ w; w.x = cvt_pk_bf16(o[0], o[1]); w.y = cvt_pk_bf16(o[2], o[3]); *(u32x2_*)(act + (size_t)row * dff + ch0) = w; }
                    if (m == 0 && fr < 2) { bf16_t* hp = halo + ((size_t)panel * 4 + fr) * dff2 + ch0; u32x2_ w; w.x = cvt_pk_bf16(xa[0], xa[1]); w.y = cvt_pk_bf16(xa[2], xa[3]); *(u32x2_*)hp = w;
                        w.x = cvt_pk_bf16(xb[0], xb[1]); w.y = cvt_pk_bf16(xb[2], xb[3]); *(u32x2_*)(hp + dff) = w; }
                    if (m == 3 && fr >= 14) { bf16_t* hp = halo + ((size_t)panel * 4 + 2 + (fr - 14)) * dff2 + ch0; u32x2_ w; w.x = cvt_pk_bf16(xa[0], xa[1]); w.y = cvt_pk_bf16(xa[2], xa[3]); *(u32x2_*)hp = w;
                        w.x = cvt_pk_bf16(xb[0], xb[1]); w.y = cvt_pk_bf16(xb[2], xb[3]); *(u32x2_*)(hp + dff) = w; }
                    pa = xa; pb = xb;
                }
            }
        }
    }
};
template <class Epi, class Sched, bool ALIGN_EPI = false, bool SP2 = false>
__device__ __forceinline__ void gemm_phase(PG8_LAS unsigned char* lds, const Gemm g, const Sched& S, const Epi& E) {
    const int tid = threadIdx.x, wid = __builtin_amdgcn_readfirstlane(tid >> 6), lane = tid & 63, wr = wid >> 2, wc = wid & 3, fr = lane & 15, fq = lane >> 4;
    const int K = g.K, nt = K / BK;
    unsigned voffA[2], voffB[2];
#pragma unroll
    for (int i = 0; i < 2; ++i) { int R, C; stage_rc(tid * 16 + i * 8192, R, C); const int Rb = Epi::PERM ? ((R & ~31) + perm32(R & 31)) : R;
        voffA[i] = (unsigned)(R * K + C) * 2u; voffB[i] = (unsigned)(Rb * K + C) * 2u; }
    const size_t kstep = (size_t)(BK * 2);
    const size_t hstep = (size_t)HALF * K * 2;
    const size_t tstep = 2 * hstep;
    const unsigned ldsw = (unsigned)wid * 1024u;
    const int aoff = lds_byte(wr * 64 + fr, fq * 8), boff = lds_byte(wc * 32 + fr, fq * 8);
#define PG8_SA(b, h) (((b) * 2 + (h)) * HTB)
#define PG8_SB(b, h) ((4 + (b) * 2 + (h)) * HTB)
#define PG8_STAGE(bufoff, gbase, voff) do { _Pragma("unroll") for (int _i = 0; _i < 2; ++_i) \
        __builtin_amdgcn_global_load_lds((const unsigned*)((const char*)(gbase) + (voff)[_i]), (PG8_LAS unsigned*)(lds + (bufoff) + ldsw + _i * 8192), 16, 0, 0); } while (0)
#define PG8_LDA(dst, b, h) do { _Pragma("unroll") for (int m = 0; m < 4; ++m) _Pragma("unroll") for (int k = 0; k < 2; ++k) dst[m][k] = *(const PG8_LAS bf16x8*)(lds + PG8_SA(b, h) + aoff + m * 2048 + k * 1024); } while (0)
#define PG8_LDB(dst, b, h) do { _Pragma("unroll") for (int n = 0; n < 2; ++n) _Pragma("unroll") for (int k = 0; k < 2; ++k) dst[n][k] = *(const PG8_LAS bf16x8*)(lds + PG8_SB(b, h) + boff + n * 2048 + k * 1024); } while (0)
#define PG8_MMA(ai, bj, At, Bt) do { __builtin_amdgcn_s_setprio(1); _Pragma("unroll") for (int m = 0; m < 4; ++m) _Pragma("unroll") for (int n = 0; n < 2; ++n) _Pragma("unroll") for (int k = 0; k < 2; ++k) \
        acc[ai][bj][m][n] = __builtin_amdgcn_mfma_f32_16x16x32_bf16(Bt[n][k], At[m][k], acc[ai][bj][m][n], 0, 0, 0); __builtin_amdgcn_s_setprio(0); } while (0)
#define PG8_WAIT_V(n) asm volatile("s_waitcnt vmcnt(" #n ")" ::: "memory")
#define PG8_WAIT_L(n) asm volatile("s_waitcnt lgkmcnt(" #n ")" ::: "memory")
#define PG8_BAR __builtin_amdgcn_s_barrier()
#define PG8_SCHED __builtin_amdgcn_sched_barrier(0)
    Unit cur, nxt; int ui = 0;
    if (!S.next(0, cur)) return;
    f32x4 acc[2][2][4][2];
#pragma unroll
    for (int a = 0; a < 2; ++a)
#pragma unroll
        for (int b = 0; b < 2; ++b)
#pragma unroll
            for (int m = 0; m < 4; ++m)
#pragma unroll
                for (int n = 0; n < 2; ++n) acc[a][b][m][n] = (f32x4){0.f, 0.f, 0.f, 0.f};
    bf16x8 At[4][2], B0[2][2], B1[2][2];
    const char* cA = (const char*)g.A + (size_t)cur.pm * tstep; const char* cB = (const char*)g.Bt + (size_t)cur.pn * tstep;
    S.a_ready(cur);
    if constexpr (SP2) {
        PG8_STAGE(PG8_SB(0, 0), cB, voffB); PG8_STAGE(PG8_SB(0, 1), cB + hstep, voffB); PG8_STAGE(PG8_SA(0, 0), cA, voffA); PG8_STAGE(PG8_SA(0, 1), cA + hstep, voffA);
        if (wr == 1) PG8_BAR;
        PG8_WAIT_V(2); PG8_BAR;
        PG8_STAGE(PG8_SB(1, 0), cB + kstep, voffB); PG8_STAGE(PG8_SA(1, 0), cA + kstep, voffA); PG8_STAGE(PG8_SB(1, 1), cB + hstep + kstep, voffB);
        PG8_WAIT_V(6); PG8_BAR;
    } else {
        PG8_STAGE(PG8_SB(0, 0), cB, voffB); PG8_STAGE(PG8_SA(0, 0), cA, voffA); PG8_STAGE(PG8_SB(0, 1), cB + hstep, voffB); PG8_STAGE(PG8_SA(0, 1), cA + hstep, voffA);
        if (wr == 1) PG8_BAR;
        PG8_WAIT_V(4); PG8_BAR;
        PG8_STAGE(PG8_SB(1, 0), cB + kstep, voffB); PG8_STAGE(PG8_SA(1, 0), cA + kstep, voffA); PG8_STAGE(PG8_SB(1, 1), cB + hstep + kstep, voffB);
        PG8_WAIT_V(6); PG8_BAR;
    }
    for (;;) {
        const bool has_next = S.next(ui + 1, nxt);
        const char* nA = has_next ? (const char*)g.A + (size_t)nxt.pm * tstep : cA; const char* nB = has_next ? (const char*)g.Bt + (size_t)nxt.pn * tstep : cB;
        for (int t = 0; t < nt; t += 2) {
            const bool last = (t == nt - 2);
            const char* a1 = cA + (size_t)(t + 1) * kstep;
            const char* a2 = last ? nA : cA + (size_t)(t + 2) * kstep; const char* b2 = last ? nB : cB + (size_t)(t + 2) * kstep;
            const char* a3 = a2 + kstep; const char* b3 = b2 + kstep;
            if (last && has_next) S.a_ready(nxt);
            if constexpr (SP2) {
            PG8_LDB(B0, 0, 0); PG8_LDB(B1, 0, 1); PG8_SCHED; PG8_LDA(At, 0, 0); PG8_STAGE(PG8_SA(1, 1), a1 + hstep, voffA);
            PG8_WAIT_V(8); PG8_WAIT_L(0); PG8_BAR; PG8_MMA(0, 0, At, B0); PG8_MMA(0, 1, At, B1); PG8_BAR; PG8_SCHED;
            PG8_LDA(At, 0, 1); PG8_STAGE(PG8_SB(0, 0), b2, voffB); PG8_STAGE(PG8_SB(0, 1), b2 + hstep, voffB); PG8_STAGE(PG8_SA(0, 0), a2, voffA);
            PG8_WAIT_V(8); PG8_WAIT_L(0); PG8_BAR; PG8_MMA(1, 0, At, B0); PG8_MMA(1, 1, At, B1); PG8_BAR; PG8_SCHED;
            PG8_LDB(B0, 1, 0); PG8_LDB(B1, 1, 1); PG8_SCHED; PG8_LDA(At, 1, 0); PG8_STAGE(PG8_SA(0, 1), a2 + hstep, voffA);
            PG8_WAIT_V(8); PG8_WAIT_L(0); PG8_BAR; PG8_MMA(0, 0, At, B0); PG8_MMA(0, 1, At, B1); PG8_BAR; PG8_SCHED;
            PG8_LDA(At, 1, 1); PG8_STAGE(PG8_SB(1, 0), b3, voffB); PG8_STAGE(PG8_SB(1, 1), b3 + hstep, voffB); PG8_STAGE(PG8_SA(1, 0), a3, voffA);
            PG8_WAIT_V(8); PG8_WAIT_L(0); PG8_BAR; PG8_MMA(1, 0, At, B0); PG8_MMA(1, 1, At, B1); PG8_BAR; PG8_SCHED;
            } else {
            PG8_LDB(B0, 0, 0); PG8_SCHED; PG8_LDA(At, 0, 0); PG8_STAGE(PG8_SA(1, 1), a1 + hstep, voffA);
            PG8_WAIT_L(8); PG8_BAR; PG8_WAIT_L(0); PG8_MMA(0, 0, At, B0); PG8_BAR; PG8_SCHED;
            PG8_LDB(B1, 0, 1); PG8_STAGE(PG8_SB(0, 0), b2, voffB);
            PG8_BAR; PG8_WAIT_L(0); PG8_MMA(0, 1, At, B1); PG8_BAR;
            PG8_LDA(At, 0, 1); PG8_STAGE(PG8_SA(0, 0), a2, voffA);
            PG8_BAR; PG8_WAIT_L(0); PG8_MMA(1, 0, At, B0); PG8_BAR; PG8_SCHED;
            PG8_STAGE(PG8_SB(0, 1), b2 + hstep, voffB);
            PG8_WAIT_V(6); PG8_BAR; PG8_MMA(1, 1, At, B1); PG8_BAR;
            PG8_LDB(B0, 1, 0); PG8_SCHED; PG8_LDA(At, 1, 0); PG8_STAGE(PG8_SA(0, 1), a2 + hstep, voffA);
            PG8_WAIT_L(8); PG8_BAR; PG8_WAIT_L(0); PG8_MMA(0, 0, At, B0); PG8_BAR; PG8_SCHED;
            PG8_LDB(B1, 1, 1); PG8_STAGE(PG8_SB(1, 0), b3, voffB);
            PG8_BAR; PG8_WAIT_L(0); PG8_MMA(0, 1, At, B1); PG8_BAR;
            PG8_LDA(At, 1, 1); PG8_STAGE(PG8_SA(1, 0), a3, voffA);
            PG8_BAR; PG8_WAIT_L(0); PG8_MMA(1, 0, At, B0); PG8_BAR; PG8_SCHED;
            PG8_STAGE(PG8_SB(1, 1), b3 + hstep, voffB);
            PG8_WAIT_V(6); PG8_BAR; PG8_MMA(1, 1, At, B1); PG8_BAR;
            }
        }
        if constexpr (ALIGN_EPI) { if (wr == 0) PG8_BAR; }
        if constexpr (!Epi::AFTER_DRAIN) { E(acc, cur, wr, wc, fr, fq); S.done(cur); }
        if (!has_next) break;
#pragma unroll
        for (int a = 0; a < 2; ++a)
#pragma unroll
            for (int b = 0; b < 2; ++b)
#pragma unroll
                for (int m = 0; m < 4; ++m)
#pragma unroll
                    for (int n = 0; n < 2; ++n) acc[a][b][m][n] = (f32x4){0.f, 0.f, 0.f, 0.f};
        cur = nxt; cA = nA; cB = nB; ++ui;
        if constexpr (ALIGN_EPI) { if (wr == 1) PG8_BAR; }
    }
    PG8_WAIT_V(0);
    if constexpr (!ALIGN_EPI) { if (wr == 0) PG8_BAR; }
    PG8_BAR;
    if constexpr (Epi::AFTER_DRAIN) { E.fused(acc, cur, wr, wc, fr, fq, lds, wid, lane); S.done(cur); }
#undef PG8_SA
#undef PG8_SB
#undef PG8_STAGE
#undef PG8_LDA
#undef PG8_LDB
#undef PG8_MMA
#undef PG8_WAIT_V
#undef PG8_WAIT_L
#undef PG8_BAR
#undef PG8_SCHED
}

}
#define LAS __attribute__((address_space(3)))
typedef unsigned short bf16;
typedef short bf16x8 __attribute__((ext_vector_type(8)));
typedef short s16x4 __attribute__((ext_vector_type(4)));
typedef float f32x16 __attribute__((ext_vector_type(16)));
typedef float f32x4 __attribute__((ext_vector_type(4)));
typedef unsigned u32x4 __attribute__((ext_vector_type(4)));
typedef unsigned u32x2 __attribute__((ext_vector_type(2)));

constexpr int S = 8192, DM = 4096, NIN = 7240, NINP = 7424, DFF = 11008, DFF2 = 22016;
constexpr int C_Q = 1024, C_KC = 4096, C_VC = 4608, C_KS = 5120, C_VS = 5632, C_KW = 6144, C_VW = 6656, C_GL = 7168;
constexpr float LOG2E = 1.4426950408889634f;
constexpr float C2S = 0.08838834764831845f * 1.4426950408889634f;
constexpr float RMS_EPS = 1e-6f;

constexpr size_t MiB = 1u << 20;
constexpr size_t WS_CTL = 0, CTL_BYTES = 65536;
constexpr size_t WS_WIN_T = 1 * MiB;
constexpr size_t WS_WOUT_T = 59 * MiB;
constexpr size_t WS_WUP_T = 91 * MiB;
constexpr size_t WS_WDN_T = 263 * MiB;
constexpr size_t WS_SMALL = 349 * MiB;
constexpr size_t WS_PWT = WS_SMALL;
constexpr size_t WS_W1KT = WS_SMALL + 1 * MiB;
constexpr size_t WS_W1VT = WS_SMALL + 2 * MiB;
constexpr size_t WS_W2KT = WS_SMALL + 3 * MiB;
constexpr size_t WS_W2VT = WS_SMALL + 3 * MiB + 65536;
constexpr size_t WS_C1P = WS_SMALL + 3 * MiB + 131072;
constexpr size_t WS_CK = WS_SMALL + 4 * MiB;
constexpr size_t WS_CV = WS_SMALL + 5 * MiB;
constexpr size_t WS_SEL = WS_SMALL + 6 * MiB;
constexpr size_t WS_HN = 357 * MiB;
constexpr size_t WS_PROJ = 421 * MiB;
constexpr size_t WS_MIX = 537 * MiB;
constexpr size_t WS_ACT = WS_PROJ;
constexpr size_t WS_SCR = 601 * MiB;
constexpr size_t WS_H1 = 665 * MiB;
constexpr size_t WS_U = 793 * MiB;
constexpr size_t WS_END = 1137 * MiB;

constexpr int RING_BYTES = 131072;
constexpr int LDS_BIAS = RING_BYTES;
constexpr int LDS_AL = LDS_BIAS + 24 * 128 * 4;
constexpr int LDS_MISC = LDS_AL + 8 * 64 * 4;
constexpr int LDS_BYTES = 147456;
static_assert(LDS_MISC + 64 <= LDS_BYTES, "lds map");

struct Params { const float* in[19]; float* out; unsigned char* ws; int ph_lo, ph_hi; };

#define LDS_WAIT() asm volatile("s_waitcnt lgkmcnt(0)" ::: "memory")
__device__ __forceinline__ unsigned cvtpk(float lo, float hi) { unsigned r; asm volatile("v_cvt_pk_bf16_f32 %0, %1, %2" : "=v"(r) : "v"(lo), "v"(hi)); return r; }
__device__ __forceinline__ float bf2f(unsigned short b) { return __uint_as_float(((unsigned)b) << 16); }
__device__ __forceinline__ bf16x8 pack8(f32x4 a, f32x4 b) { u32x4 w = {cvtpk(a[0], a[1]), cvtpk(a[2], a[3]), cvtpk(b[0], b[1]), cvtpk(b[2], b[3])}; return __builtin_bit_cast(bf16x8, w); }
__device__ __forceinline__ bf16x8 ld8(const bf16* p) { return *reinterpret_cast<const bf16x8*>(p); }
__device__ __forceinline__ float wave_sum(float v) {
#pragma unroll
    for (int o = 1; o < 64; o <<= 1) v += __shfl_xor(v, o);
    return v;
}
__device__ __forceinline__ float sigmoidf_(float x) { return __builtin_amdgcn_rcpf(1.f + __builtin_amdgcn_exp2f(x * -1.4426950408889634f)); }

template <bool REMAP = false, bool NT = false>
__device__ __forceinline__ void tr_item(const float* __restrict__ W, int K, int N, bf16* __restrict__ WT, LAS float* scr, int item, int lane, const float* __restrict__ rs = nullptr) {
    const int nblk = (N + 31) >> 5, kb = item / nblk, nb = item - kb * nblk, k0 = 64 * kb, n0 = 32 * nb;
    const int nn = n0 + (lane & 31); const bool ok = nn < N;
    float tv[32];
#pragma unroll
    for (int i = 0; i < 32; ++i) { const int kk = 2 * i + (lane >> 5); tv[i] = ok ? __builtin_nontemporal_load(W + (size_t)(k0 + kk) * N + nn) : 0.f; }
    if (rs) {
#pragma unroll
        for (int i = 0; i < 32; ++i) tv[i] *= rs[k0 + 2 * i + (lane >> 5)]; }
#pragma unroll
    for (int i = 0; i < 32; ++i) { const int kk = 2 * i + (lane >> 5); scr[kk * 33 + (lane & 31)] = tv[i]; }
    LDS_WAIT(); asm volatile("" ::: "memory");
    const int c = lane & 7;
#pragma unroll
    for (int j = 0; j < 4; ++j) { const int n = (lane >> 3) + 8 * j; const LAS float* s = scr + (8 * c) * 33 + n;
        u32x4 o; o.x = cvtpk(s[0 * 33], s[1 * 33]); o.y = cvtpk(s[2 * 33], s[3 * 33]); o.z = cvtpk(s[4 * 33], s[5 * 33]); o.w = cvtpk(s[6 * 33], s[7 * 33]);
        const int nn_ = n0 + n; int no = nn_;
        if (REMAP) no = nn_ < DFF ? ((nn_ >> 7) * 256 + (nn_ & 127)) : (((nn_ - DFF) >> 7) * 256 + 128 + ((nn_ - DFF) & 127));
        if (nn_ < N) { u32x4* dp = (u32x4*)(WT + (size_t)no * K + k0 + 8 * c); if (NT) __builtin_nontemporal_store(o, dp); else *dp = o; } }
    LDS_WAIT(); asm volatile("" ::: "memory");
}
__device__ __forceinline__ void rms_row_bf16(const float* __restrict__ xrow, const float* __restrict__ g, bf16* __restrict__ orow, int lane) {
    const f32x4* xr = (const f32x4*)xrow + lane; f32x4 v[16]; float s = 0.f;
#pragma unroll
    for (int j = 0; j < 16; ++j) { v[j] = xr[64 * j]; s += (v[j].x * v[j].x + v[j].y * v[j].y) + (v[j].z * v[j].z + v[j].w * v[j].w); }
    const float r = rsqrtf(wave_sum(s) * (1.f / DM) + RMS_EPS);
    const f32x4* gr = (const f32x4*)g + lane; u32x2* o8 = (u32x2*)orow + lane;
#pragma unroll
    for (int j = 0; j < 16; ++j) { const f32x4 gv = gr[64 * j]; u32x2 w; w.x = cvtpk(v[j].x * r * gv.x, v[j].y * r * gv.y); w.y = cvtpk(v[j].z * r * gv.z, v[j].w * r * gv.w); o8[64 * j] = w; }
}
__device__ __forceinline__ void rms_row_f32(const float* xrow, const float* __restrict__ g, float* orow, int lane) {
    const f32x4* xr = (const f32x4*)xrow + lane; f32x4 v[16]; float s = 0.f;
#pragma unroll
    for (int j = 0; j < 16; ++j) { v[j] = xr[64 * j]; s += (v[j].x * v[j].x + v[j].y * v[j].y) + (v[j].z * v[j].z + v[j].w * v[j].w); }
    const float r = rsqrtf(wave_sum(s) * (1.f / DM) + RMS_EPS);
    const f32x4* gr = (const f32x4*)g + lane; f32x4* o = (f32x4*)orow + lane;
#pragma unroll
    for (int j = 0; j < 16; ++j) { const f32x4 gv = gr[64 * j]; o[64 * j] = v[j] * r * gv; }
}


__device__ __forceinline__ void rms_row_b2f(const bf16* __restrict__ xrow, const float* __restrict__ g, float* __restrict__ orow, int lane) {
    const u32x4* xr = (const u32x4*)xrow + lane; u32x4 v[8]; float s = 0.f;
#pragma unroll
    for (int j = 0; j < 8; ++j) { v[j] = xr[64 * j];
        const float a0 = __uint_as_float(v[j].x << 16), a1 = __uint_as_float(v[j].x & 0xffff0000u), a2 = __uint_as_float(v[j].y << 16), a3 = __uint_as_float(v[j].y & 0xffff0000u);
        const float a4 = __uint_as_float(v[j].z << 16), a5 = __uint_as_float(v[j].z & 0xffff0000u), a6 = __uint_as_float(v[j].w << 16), a7 = __uint_as_float(v[j].w & 0xffff0000u);
        s += ((a0 * a0 + a1 * a1) + (a2 * a2 + a3 * a3)) + ((a4 * a4 + a5 * a5) + (a6 * a6 + a7 * a7)); }
    const float r = rsqrtf(wave_sum(s) * (1.f / DM) + RMS_EPS);
#pragma unroll
    for (int j = 0; j < 8; ++j) { const int c = (lane + 64 * j) * 8; const f32x4 g0 = *(const f32x4*)(g + c), g1 = *(const f32x4*)(g + c + 4);
        f32x4 o0, o1;
        o0.x = __uint_as_float(v[j].x << 16) * r * g0.x; o0.y = __uint_as_float(v[j].x & 0xffff0000u) * r * g0.y; o0.z = __uint_as_float(v[j].y << 16) * r * g0.z; o0.w = __uint_as_float(v[j].y & 0xffff0000u) * r * g0.w;
        o1.x = __uint_as_float(v[j].z << 16) * r * g1.x; o1.y = __uint_as_float(v[j].z & 0xffff0000u) * r * g1.y; o1.z = __uint_as_float(v[j].w << 16) * r * g1.z; o1.w = __uint_as_float(v[j].w & 0xffff0000u) * r * g1.w;
        __builtin_nontemporal_store(o0, (f32x4*)(orow + c)); __builtin_nontemporal_store(o1, (f32x4*)(orow + c + 4)); }
}
#define KSWZ(row, colB) ((row) * 256 + ((colB) ^ (((row) & 7) << 4)))
#define SBAR() __builtin_amdgcn_sched_barrier(0)
constexpr int SHM_V = 16384, SHM_K = 16384;
__device__ __forceinline__ int v_st(int k, int c) { const int kk = (k & ~0xC) | ((k & 4) << 1) | ((k & 8) >> 1); return ((kk >> 3) * 4 + (c >> 5)) * 512 + ((kk & 7) * 32 + (c & 31)) * 2; }
__device__ __forceinline__ int v_rd_base(int lane) { return ((lane & 3) << 3) | (((lane >> 2) & 3) << 6) | (((lane >> 4) & 1) << 5) | (((lane >> 5) & 1) << 8); }
constexpr int v_rd_off(int d0, int ks, int half) { return d0 * 512 + ks * 4096 + half * 2048; }
__device__ __forceinline__ int crow(int r, int hi) { return (r & 3) + 8 * (r >> 2) + 4 * hi; }

template <int MODE>
__device__ __forceinline__ void score_tile(f32x16& p0, f32x16& p1, int dq, const LAS float* brow, float b31, bool far, bool sel) {
    const float NEG = -__builtin_inff();
    if (far && MODE == 1) {
#pragma unroll
        for (int r = 0; r < 16; ++r) { p0[r] = sel ? fmaf(p0[r], C2S, b31) : NEG; p1[r] = sel ? fmaf(p1[r], C2S, b31) : NEG; }
    } else if (far) {
#pragma unroll
        for (int r = 0; r < 16; ++r) {
            const int c = (r & 3) + 8 * (r >> 2);
            const int d0 = (MODE == 0) ? dq - 16 * c : dq - c, d1 = (MODE == 0) ? d0 - 512 : d0 - 32;
            bool v0, v1;
            if (MODE == 0) { v0 = d0 >= 0; v1 = d1 >= 0; } else if (MODE == 1) { v0 = sel && d0 >= 0; v1 = sel && d1 >= 0; } else { v0 = (unsigned)d0 < 512u; v1 = (unsigned)d1 < 512u; }
            p0[r] = v0 ? fmaf(p0[r], C2S, b31) : NEG; p1[r] = v1 ? fmaf(p1[r], C2S, b31) : NEG;
        }
    } else {
#pragma unroll
        for (int r = 0; r < 16; ++r) {
            const int c = (r & 3) + 8 * (r >> 2);
            const int d0 = (MODE == 0) ? dq - 16 * c : dq - c, d1 = (MODE == 0) ? d0 - 512 : d0 - 32;
            bool v0, v1;
            if (MODE == 0) { v0 = d0 >= 0; v1 = d1 >= 0; } else if (MODE == 1) { v0 = sel && d0 >= 0; v1 = sel && d1 >= 0; } else { v0 = (unsigned)d0 < 512u; v1 = (unsigned)d1 < 512u; }
            const float bb0 = brow[min(max(d0, 0), 127)];
            p0[r] = v0 ? fmaf(p0[r], C2S, bb0) : NEG; (void)v1;
        }
        SBAR();
#pragma unroll
        for (int r = 0; r < 16; ++r) {
            const int c = (r & 3) + 8 * (r >> 2);
            const int d0 = (MODE == 0) ? dq - 16 * c : dq - c, d1 = (MODE == 0) ? d0 - 512 : d0 - 32;
            bool v1;
            if (MODE == 0) { v1 = d1 >= 0; } else if (MODE == 1) { v1 = sel && d1 >= 0; } else { v1 = (unsigned)d1 < 512u; }
            const float bb1 = brow[min(max(d1, 0), 127)];
            p1[r] = v1 ? fmaf(p1[r], C2S, bb1) : NEG;
        }
    }
}
__device__ __forceinline__ float half_max(float v) { auto rr = __builtin_amdgcn_permlane32_swap(__float_as_uint(v), __float_as_uint(v), false, false); return fmaxf(__uint_as_float(rr[0]), __uint_as_float(rr[1])); }
__device__ __forceinline__ float half_sum(float v) { auto rr = __builtin_amdgcn_permlane32_swap(__float_as_uint(v), __float_as_uint(v), false, false); return __uint_as_float(rr[0]) + __uint_as_float(rr[1]); }

__device__ __forceinline__ void pv_tile(f32x16 (&o)[4], int vb0, bf16x8 pa0, bf16x8 pa1, bf16x8 pa2, bf16x8 pa3) {
#define TRRD(dst, off) asm volatile("ds_read_b64_tr_b16 %0, %1 offset:%2" : "=&v"(dst) : "v"(vb0), "i"(off) : "memory")
#define PV_D0(d0) do { s16x4 l0, l1, l2, l3, h0, h1, h2, h3; constexpr int b_ = v_rd_off(d0, 0, 0); \
        TRRD(l0, b_); TRRD(h0, b_ + 2048); TRRD(l1, b_ + 4096); TRRD(h1, b_ + 6144); TRRD(l2, b_ + 8192); TRRD(h2, b_ + 10240); TRRD(l3, b_ + 12288); TRRD(h3, b_ + 14336); \
        asm volatile("s_waitcnt lgkmcnt(0)" ::: "memory"); SBAR(); \
        o[d0] = __builtin_amdgcn_mfma_f32_32x32x16_bf16(pa0, (bf16x8){l0[0], l0[1], l0[2], l0[3], h0[0], h0[1], h0[2], h0[3]}, o[d0], 0, 0, 0); \
        o[d0] = __builtin_amdgcn_mfma_f32_32x32x16_bf16(pa1, (bf16x8){l1[0], l1[1], l1[2], l1[3], h1[0], h1[1], h1[2], h1[3]}, o[d0], 0, 0, 0); \
        o[d0] = __builtin_amdgcn_mfma_f32_32x32x16_bf16(pa2, (bf16x8){l2[0], l2[1], l2[2], l2[3], h2[0], h2[1], h2[2], h2[3]}, o[d0], 0, 0, 0); \
        o[d0] = __builtin_amdgcn_mfma_f32_32x32x16_bf16(pa3, (bf16x8){l3[0], l3[1], l3[2], l3[3], h3[0], h3[1], h3[2], h3[3]}, o[d0], 0, 0, 0); } while (0)
    PV_D0(0); PV_D0(1); PV_D0(2); PV_D0(3);
#undef PV_D0
#undef TRRD
}

template <int MODE>
__device__ __forceinline__ void attn_tile(const LAS char* Kb, int vb0, const bf16x8 (&qr)[8], int r32, int hi, int dq, const LAS float* brow, float b31, bool far, bool sel,
                                          float& m_reg, float& l_reg, f32x16 (&o)[4], LAS float* al_l) {
    f32x16 p0 = {}, p1 = {};
    const LAS char* kbp[4];
#pragma unroll
    for (int dd = 0; dd < 4; ++dd) kbp[dd] = Kb + KSWZ(r32, (dd * 16 + hi * 8) * 2);
#pragma unroll
    for (int d0 = 0; d0 < 8; ++d0) { const LAS char* a = kbp[d0 & 3] + (d0 >> 2) * 128;
        const bf16x8 b0 = *reinterpret_cast<const LAS bf16x8*>(a), b1 = *reinterpret_cast<const LAS bf16x8*>(a + 32 * 256);
        p0 = __builtin_amdgcn_mfma_f32_32x32x16_bf16(b0, qr[d0], p0, 0, 0, 0);
        p1 = __builtin_amdgcn_mfma_f32_32x32x16_bf16(b1, qr[d0], p1, 0, 0, 0); }
    float mn, alpha, ps = 0.f;
    if (far && MODE != 2) {
        float rmax = p0[0];
#pragma unroll
        for (int r = 1; r < 16; ++r) rmax = fmaxf(rmax, p0[r]);
#pragma unroll
        for (int r = 0; r < 16; ++r) rmax = fmaxf(rmax, p1[r]);
        rmax = half_max(rmax);
        const float NEGI = -__builtin_inff();
        const float pmax = sel ? fmaf(rmax, C2S, b31) : NEGI;
        if (__builtin_expect(__all(pmax - m_reg <= 8.f), 1)) { mn = m_reg; alpha = 1.f; }
        else { mn = fmaxf(m_reg, pmax); alpha = __builtin_amdgcn_exp2f(m_reg - mn); m_reg = mn; }
        const float t = sel ? b31 - mn : NEGI;
#pragma unroll
        for (int r = 0; r < 16; ++r) { p0[r] = __builtin_amdgcn_exp2f(fmaf(p0[r], C2S, t)); ps += p0[r]; }
#pragma unroll
        for (int r = 0; r < 16; ++r) { p1[r] = __builtin_amdgcn_exp2f(fmaf(p1[r], C2S, t)); ps += p1[r]; }
    } else {
        score_tile<MODE>(p0, p1, dq, brow, b31, far, sel);
        float pmax = p0[0];
#pragma unroll
        for (int r = 1; r < 16; ++r) pmax = fmaxf(pmax, p0[r]);
#pragma unroll
        for (int r = 0; r < 16; ++r) pmax = fmaxf(pmax, p1[r]);
        pmax = half_max(pmax);
        if (__builtin_expect(__all(pmax - m_reg <= 8.f), 1)) { mn = m_reg; alpha = 1.f; }
        else { mn = fmaxf(m_reg, pmax); alpha = __builtin_amdgcn_exp2f(m_reg - mn); m_reg = mn; }
#pragma unroll
        for (int r = 0; r < 16; ++r) { p0[r] = __builtin_amdgcn_exp2f(p0[r] - mn); ps += p0[r]; }
#pragma unroll
        for (int r = 0; r < 16; ++r) { p1[r] = __builtin_amdgcn_exp2f(p1[r] - mn); ps += p1[r]; }
    }
    ps = half_sum(ps);
    l_reg = l_reg * alpha + ps;
    if (__any(alpha < 1.f)) { if (hi == 0) al_l[r32] = alpha; LDS_WAIT();
#pragma unroll
        for (int r = 0; r < 16; ++r) { const float a = al_l[crow(r, hi)];
#pragma unroll
            for (int d = 0; d < 4; ++d) o[d][r] *= a; }
        LDS_WAIT(); }
    bf16x8 pa0, pa1, pa2, pa3;
#define PK4(P, B_, OUT) do { unsigned a0 = cvtpk(P[B_+0], P[B_+1]), a1 = cvtpk(P[B_+2], P[B_+3]); \
        unsigned b0_ = cvtpk(P[B_+4], P[B_+5]), b1_ = cvtpk(P[B_+6], P[B_+7]); \
        auto r0 = __builtin_amdgcn_permlane32_swap(a0, b0_, false, false); auto r1 = __builtin_amdgcn_permlane32_swap(a1, b1_, false, false); \
        u32x4 w = {r0[0], r1[0], r0[1], r1[1]}; OUT = __builtin_bit_cast(bf16x8, w); } while (0)
    PK4(p0, 0, pa0); PK4(p0, 8, pa1); PK4(p1, 0, pa2); PK4(p1, 8, pa3);
#undef PK4
    pv_tile(o, vb0, pa0, pa1, pa2, pa3);
}

template <int MODE>
__device__ __forceinline__ void attn_branch(const bf16* __restrict__ Kp, const bf16* __restrict__ Vp, int stride, int j_lo, int j_hi, LAS unsigned char* lds,
                                            const bf16x8 (&qr)[8], int tq0, int tpos, const LAS float* brow, float b31, u32x4 selw,
                                            float& m_reg, float& l_reg, f32x16 (&o)[4], LAS float* al_l, int tid, int lane) {
    const int r32 = lane & 31, hi = lane >> 5, sr = tid >> 4, sc = (tid & 15) * 8;
    const int kws = KSWZ(sr, sc * 2), vst0 = v_st(sr, sc), vst1 = v_st(32 + sr, sc);
    m_reg = -1e30f; l_reg = 0.f;
#pragma unroll
    for (int d = 0; d < 4; ++d) o[d] = f32x16{};
    bf16x8 sk0, sk1, sv0, sv1;
#define BLOAD(j) do { const size_t r0_ = (size_t)((j) * 64 + sr) * stride + sc, r1_ = r0_ + (size_t)32 * stride; \
        sk0 = ld8(Kp + r0_); sk1 = ld8(Kp + r1_); sv0 = ld8(Vp + r0_); sv1 = ld8(Vp + r1_); } while (0)
    BLOAD(j_lo);
    for (int j = j_lo; j < j_hi; ++j) {
        const int buf = (j - j_lo) & 1;
        LAS char* Vb = (LAS char*)lds + buf * SHM_V; LAS char* Kb = (LAS char*)lds + 2 * SHM_V + buf * SHM_K;
        *reinterpret_cast<LAS bf16x8*>(Kb + kws) = sk0; *reinterpret_cast<LAS bf16x8*>(Kb + kws + 32 * 256) = sk1;
        *reinterpret_cast<LAS bf16x8*>(Vb + vst0) = sv0; *reinterpret_cast<LAS bf16x8*>(Vb + vst1) = sv1;
        __syncthreads();
        if (j + 1 < j_hi) BLOAD(j + 1);
        const int kb = j * 64;
        bool skip, far, sel = true; int dq;
        if (MODE == 0) { skip = 16 * kb > tq0; far = (tq0 - 31 - 16 * (kb + 63)) >= 127; dq = tpos - 31 - 16 * kb - 64 * hi; }
        else {
            far = (tq0 - (kb + 63)) >= 127; dq = tpos - kb - 4 * hi;
            if (MODE == 1) { const unsigned w = j < 32 ? selw.x : (j < 64 ? selw.y : (j < 96 ? selw.z : selw.w)); sel = (w >> (j & 31)) & 1u; skip = (kb > tq0 + 31) || !__any(sel); }
            else skip = (kb > tq0 + 31) || (kb + 63 < tq0 - 511);
        }
        if (!skip) attn_tile<MODE>(Kb, (int)(size_t)Vb + v_rd_base(lane), qr, r32, hi, dq, brow, b31, far, sel, m_reg, l_reg, o, al_l);
    }
    __syncthreads();
#undef BLOAD
}

__device__ __forceinline__ void compress_unit(int u, const bf16* __restrict__ proj, unsigned char* ws, LAS unsigned char* lds, int tid, int wid, int lane) {
    const int which = u >> 6, g = (u >> 4) & 3, nb = u & 15, fr = lane & 15, fq = lane >> 4, e0 = wid * 16;
    const bf16* src = proj + (which ? C_VC : C_KC) + g * 128;
    const bf16* w1t = (const bf16*)(ws + (which ? WS_W1VT : WS_W1KT));
    const bf16* w2t = (const bf16*)(ws + (which ? WS_W2VT : WS_W2KT));
    const float* c1p = (const float*)(ws + WS_C1P) + which * 32 * 128;
    bf16* outp = (bf16*)(ws + (which ? WS_CV : WS_CK)) + (size_t)g * 512 * 128;
    LAS float* c1s = (LAS float*)lds; LAS bf16* hs = (LAS bf16*)(lds + 1024);
    if (tid < 128) { float s = 0.f; for (int r = 0; r < 32; ++r) s += c1p[r * 128 + tid]; c1s[tid] = s; }
    __syncthreads();
    const int na = nb * 32 + fr, nb_ = na + 16;
    const bf16* a0p = src + (size_t)(16 * min(na, 510)) * NINP + fq * 8;
    const bf16* a1p = src + (size_t)(16 * min(nb_, 510)) * NINP + fq * 8;
    const bf16* bp = w1t + (size_t)(e0 + fr) * 4096 + fq * 8;
    f32x4 acc0 = {0.f, 0.f, 0.f, 0.f}, acc1 = {0.f, 0.f, 0.f, 0.f};
#pragma unroll 2
    for (int l = 0; l < 32; ++l) {
#pragma unroll
        for (int k4 = 0; k4 < 4; ++k4) {
            const bf16x8 A0 = ld8(a0p + (size_t)l * NINP + k4 * 32), A1 = ld8(a1p + (size_t)l * NINP + k4 * 32), B = ld8(bp + l * 128 + k4 * 32);
            acc0 = __builtin_amdgcn_mfma_f32_16x16x32_bf16(A0, B, acc0, 0, 0, 0);
            acc1 = __builtin_amdgcn_mfma_f32_16x16x32_bf16(A1, B, acc1, 0, 0, 0);
        }
    }
    const float cc = c1s[e0 + fr];
#pragma unroll
    for (int j = 0; j < 4; ++j) {
        float h0 = acc0[j] + cc, h1 = acc1[j] + cc; h0 = h0 * sigmoidf_(h0); h1 = h1 * sigmoidf_(h1);
        hs[(fq * 4 + j) * 136 + e0 + fr] = (bf16)(cvtpk(h0, 0.f) & 0xffffu); hs[(16 + fq * 4 + j) * 136 + e0 + fr] = (bf16)(cvtpk(h1, 0.f) & 0xffffu);
    }
    __syncthreads();
    f32x4 o0 = {0.f, 0.f, 0.f, 0.f}, o1 = {0.f, 0.f, 0.f, 0.f};
#pragma unroll
    for (int ks = 0; ks < 4; ++ks) {
        const bf16x8 A0 = *reinterpret_cast<const LAS bf16x8*>(hs + fr * 136 + ks * 32 + fq * 8), A1 = *reinterpret_cast<const LAS bf16x8*>(hs + (16 + fr) * 136 + ks * 32 + fq * 8);
        const bf16x8 B = ld8(w2t + (size_t)(e0 + fr) * 128 + ks * 32 + fq * 8);
        o0 = __builtin_amdgcn_mfma_f32_16x16x32_bf16(A0, B, o0, 0, 0, 0);
        o1 = __builtin_amdgcn_mfma_f32_16x16x32_bf16(A1, B, o1, 0, 0, 0);
    }
#pragma unroll
    for (int j = 0; j < 4; ++j) {
        const int n0 = nb * 32 + fq * 4 + j, n1 = n0 + 16;
        outp[(size_t)n0 * 128 + e0 + fr] = n0 < 511 ? (bf16)(cvtpk(o0[j], 0.f) & 0xffffu) : (bf16)0;
        outp[(size_t)n1 * 128 + e0 + fr] = n1 < 511 ? (bf16)(cvtpk(o1[j], 0.f) & 0xffffu) : (bf16)0;
    }
    __syncthreads();
}


__device__ __forceinline__ void compress_naive(int u4, const bf16* __restrict__ proj, const float* pek, const float* w1k, const float* w2k, const float* pev, const float* w1v, const float* w2v, unsigned char* ws, LAS unsigned char* lds, int tid) {
    const int which = u4 >> 9, g = (u4 >> 7) & 3, nq = u4 & 127, sub = tid >> 7, e = tid & 127, n = nq * 4 + sub;
    const float* pe = which ? pev : pek; const float* w1 = which ? w1v : w1k; const float* w2 = which ? w2v : w2k;
    const bf16* src = proj + (which ? C_VC : C_KC) + g * 128;
    bf16* outp = (bf16*)(ws + (which ? WS_CV : WS_CK)) + (size_t)g * 512 * 128;
    LAS float* hsn = (LAS float*)lds;
    float acc = 0.f;
    if (n < 511) for (int kk = 0; kk < 4096; ++kk) { const int l = kk >> 7, d = kk & 127; const float a = bf2f(src[(size_t)(16 * n + l) * NINP + d]) + pe[kk]; acc += a * w1[(size_t)kk * 128 + e]; }
    hsn[sub * 128 + e] = acc * sigmoidf_(acc);
    __syncthreads();
    float o = 0.f;
    for (int k = 0; k < 128; ++k) o += hsn[sub * 128 + k] * w2[k * 128 + e];
    outp[(size_t)n * 128 + e] = n < 511 ? (bf16)(cvtpk(o, 0.f) & 0xffffu) : (bf16)0;
    __syncthreads();
}


__device__ __forceinline__ void compress_v2(int u, const bf16* __restrict__ proj, const float* __restrict__ pek, const float* __restrict__ w1k, const float* __restrict__ w2k,
                                            const float* __restrict__ pev, const float* __restrict__ w1v, const float* __restrict__ w2v, unsigned char* ws, LAS unsigned char* lds, int tid) {
    const int which = u >> 7, g = (u >> 5) & 3, nq = u & 31, e = tid & 127, sub = tid >> 7;
    const float* pe = which ? pev : pek; const float* w1 = which ? w1v : w1k; const float* w2 = which ? w2v : w2k;
    const bf16* src = proj + (which ? C_VC : C_KC) + g * 128;
    bf16* outp = (bf16*)(ws + (which ? WS_CV : WS_CK)) + (size_t)g * 512 * 128;
    LAS float* As = (LAS float*)lds;
    const int srow = tid >> 5, sd4 = (tid & 31) * 4, sn = min(nq * 16 + srow, 510);
    const bf16* sp = src + (size_t)(16 * sn) * NINP + sd4;
    float acc[4] = {0.f, 0.f, 0.f, 0.f};
    u32x2 raw = *(const u32x2*)(sp); f32x4 pv = *(const f32x4*)(pe + sd4);
    for (int l = 0; l < 32; ++l) {
        LAS float* Ab = As + (l & 1) * 2048;
        { f32x4 a; a[0] = __uint_as_float(raw.x << 16) + pv[0]; a[1] = __uint_as_float(raw.x & 0xffff0000u) + pv[1]; a[2] = __uint_as_float(raw.y << 16) + pv[2]; a[3] = __uint_as_float(raw.y & 0xffff0000u) + pv[3];
          *reinterpret_cast<LAS f32x4*>(Ab + srow * 128 + sd4) = a; }
        __syncthreads();
        if (l + 1 < 32) { raw = *(const u32x2*)(sp + (size_t)(l + 1) * NINP); pv = *(const f32x4*)(pe + (l + 1) * 128 + sd4); }
        const float* wp = w1 + (size_t)(l * 128) * 128 + e; const LAS float* ar = Ab + sub * 4 * 128;
#pragma unroll 4
        for (int d4 = 0; d4 < 32; ++d4) {
            const float w0 = wp[(d4 * 4 + 0) * 128], w1_ = wp[(d4 * 4 + 1) * 128], w2_ = wp[(d4 * 4 + 2) * 128], w3 = wp[(d4 * 4 + 3) * 128];
#pragma unroll
            for (int r = 0; r < 4; ++r) { const f32x4 a = *reinterpret_cast<const LAS f32x4*>(ar + r * 128 + d4 * 4);
                acc[r] += a[0] * w0; acc[r] += a[1] * w1_; acc[r] += a[2] * w2_; acc[r] += a[3] * w3; }
        }
    }
    __syncthreads();
    LAS float* Hs = As;
#pragma unroll
    for (int r = 0; r < 4; ++r) Hs[(sub * 4 + r) * 128 + e] = acc[r] * sigmoidf_(acc[r]);
    __syncthreads();
    float o[4] = {0.f, 0.f, 0.f, 0.f};
#pragma unroll 4
    for (int k4 = 0; k4 < 32; ++k4) {
        const float w0 = w2[(k4 * 4 + 0) * 128 + e], w1_ = w2[(k4 * 4 + 1) * 128 + e], w2_ = w2[(k4 * 4 + 2) * 128 + e], w3 = w2[(k4 * 4 + 3) * 128 + e];
#pragma unroll
        for (int r = 0; r < 4; ++r) { const f32x4 h = *reinterpret_cast<const LAS f32x4*>(Hs + (sub * 4 + r) * 128 + k4 * 4);
            o[r] += h[0] * w0; o[r] += h[1] * w1_; o[r] += h[2] * w2_; o[r] += h[3] * w3; }
    }
#pragma unroll
    for (int r = 0; r < 4; ++r) { const int n = nq * 16 + sub * 4 + r; outp[(size_t)n * 128 + e] = n < 511 ? (bf16)(cvtpk(o[r], 0.f) & 0xffffu) : (bf16)0; }
    __syncthreads();
}


__device__ __forceinline__ void compress_v3(int u, const bf16* __restrict__ proj, const float* __restrict__ pek, const float* __restrict__ pev, unsigned char* ws, LAS unsigned char* lds, int tid, int wid, int lane) {
    const int which = u >> 7, g = (u >> 5) & 3, nq = u & 31, fr = lane & 15, fq = lane >> 4, e0 = wid * 16;
    const float* pe = which ? pev : pek;
    const bf16* src = proj + (which ? C_VC : C_KC) + g * 128;
    const bf16* w1t = (const bf16*)(ws + (which ? WS_W1VT : WS_W1KT));
    const bf16* w2t = (const bf16*)(ws + (which ? WS_W2VT : WS_W2KT));
    bf16* outp = (bf16*)(ws + (which ? WS_CV : WS_CK)) + (size_t)g * 512 * 128;
    LAS bf16* As = (LAS bf16*)lds;
    LAS bf16* hs = (LAS bf16*)(lds + 16384);
    const int srow = (tid >> 4) & 15, sch = tid & 15; const bool stager = tid < 256;
    const bf16* sp = src + (size_t)(16 * min(nq * 16 + srow, 510)) * NINP + sch * 8;
    const bf16* bp = w1t + (size_t)(e0 + fr) * 4096 + fq * 8;
    bf16x8 araw = {}; f32x4 pe0 = {0.f, 0.f, 0.f, 0.f}, pe1 = {0.f, 0.f, 0.f, 0.f};
    if (stager) { araw = ld8(sp); pe0 = *(const f32x4*)(pe + sch * 8); pe1 = *(const f32x4*)(pe + sch * 8 + 4); }
    bf16x8 Bc[4];
#pragma unroll
    for (int ks = 0; ks < 4; ++ks) Bc[ks] = ld8(bp + ks * 32);
    if (stager) { f32x4 a0, a1;
#pragma unroll
        for (int i = 0; i < 4; ++i) { a0[i] = bf2f((unsigned short)araw[i]) + pe0[i]; a1[i] = bf2f((unsigned short)araw[4 + i]) + pe1[i]; }
        *reinterpret_cast<LAS bf16x8*>(As + srow * 136 + sch * 8) = pack8(a0, a1); }
    f32x4 acc[4];
#pragma unroll
    for (int ks = 0; ks < 4; ++ks) acc[ks] = (f32x4){0.f, 0.f, 0.f, 0.f};
#pragma unroll 1
    for (int l = 0; l < 32; ++l) {
        __syncthreads();
        LAS bf16* Ab = As + (l & 1) * (16 * 136);
        bf16x8 Bn[4];
        if (l + 1 < 32) {
            if (stager) { araw = ld8(sp + (size_t)(l + 1) * NINP); pe0 = *(const f32x4*)(pe + (l + 1) * 128 + sch * 8); pe1 = *(const f32x4*)(pe + (l + 1) * 128 + sch * 8 + 4); }
#pragma unroll
            for (int ks = 0; ks < 4; ++ks) Bn[ks] = ld8(bp + (l + 1) * 128 + ks * 32);
        }
#pragma unroll
        for (int ks = 0; ks < 4; ++ks) { const bf16x8 A = *reinterpret_cast<const LAS bf16x8*>(Ab + fr * 136 + ks * 32 + fq * 8);
            acc[ks] = __builtin_amdgcn_mfma_f32_16x16x32_bf16(A, Bc[ks], acc[ks], 0, 0, 0); }
        asm volatile("s_nop 7\n\ts_nop 7" ::: "memory");
        if (l + 1 < 32) {
            if (stager) { f32x4 a0, a1;
#pragma unroll
                for (int i = 0; i < 4; ++i) { a0[i] = bf2f((unsigned short)araw[i]) + pe0[i]; a1[i] = bf2f((unsigned short)araw[4 + i]) + pe1[i]; }
                *reinterpret_cast<LAS bf16x8*>(As + ((l + 1) & 1) * (16 * 136) + srow * 136 + sch * 8) = pack8(a0, a1); }
#pragma unroll
            for (int ks = 0; ks < 4; ++ks) Bc[ks] = Bn[ks];
        }
    }
    const f32x4 accs = (acc[0] + acc[1]) + (acc[2] + acc[3]);
    { const float h0 = accs.x, h1 = accs.y, h2 = accs.z, h3 = accs.w;
      hs[(fq * 4 + 0) * 136 + e0 + fr] = (bf16)(cvtpk(h0 * sigmoidf_(h0), 0.f) & 0xffffu); hs[(fq * 4 + 1) * 136 + e0 + fr] = (bf16)(cvtpk(h1 * sigmoidf_(h1), 0.f) & 0xffffu);
      hs[(fq * 4 + 2) * 136 + e0 + fr] = (bf16)(cvtpk(h2 * sigmoidf_(h2), 0.f) & 0xffffu); hs[(fq * 4 + 3) * 136 + e0 + fr] = (bf16)(cvtpk(h3 * sigmoidf_(h3), 0.f) & 0xffffu); }
    __syncthreads();
    f32x4 o4[4];
#pragma unroll
    for (int ks = 0; ks < 4; ++ks) {
        const bf16x8 A = *reinterpret_cast<const LAS bf16x8*>(hs + fr * 136 + ks * 32 + fq * 8);
        const bf16x8 B = ld8(w2t + (size_t)(e0 + fr) * 128 + ks * 32 + fq * 8);
        o4[ks] = __builtin_amdgcn_mfma_f32_16x16x32_bf16(A, B, (f32x4){0.f, 0.f, 0.f, 0.f}, 0, 0, 0);
    }
    asm volatile("s_nop 7\n\ts_nop 7" ::: "memory");
    const f32x4 os = (o4[0] + o4[1]) + (o4[2] + o4[3]);
    { const int n = nq * 16 + fq * 4; bf16* op = outp + (size_t)n * 128 + e0 + fr;
      op[0] = n + 0 < 511 ? (bf16)(cvtpk(os.x, 0.f) & 0xffffu) : (bf16)0; op[128] = n + 1 < 511 ? (bf16)(cvtpk(os.y, 0.f) & 0xffffu) : (bf16)0;
      op[256] = n + 2 < 511 ? (bf16)(cvtpk(os.z, 0.f) & 0xffffu) : (bf16)0; op[384] = n + 3 < 511 ? (bf16)(cvtpk(os.w, 0.f) & 0xffffu) : (bf16)0; }
    __syncthreads();
}

__device__ __forceinline__ void pool_unit(int u, const bf16* __restrict__ proj, const bf16* __restrict__ pwt, const float* __restrict__ pscale, bf16* __restrict__ mix,
                                          LAS unsigned char* lds, int tid, int wid, int lane) {
    const int tt = u >> 2, gi = u & 3, w = 2 << gi, fr = lane & 15, fq = lane >> 4;
    LAS bf16* dA = (LAS bf16*)lds;
    { const int c8 = tid & 31, tr = tid >> 5; const bf16* up = proj + gi * 256 + c8 * 8; const int tb = tt * 64 + tr * 4;
      float acc[4][8]; bf16x8 own[4];
#pragma unroll
      for (int q = 0; q < 4; ++q) {
#pragma unroll
          for (int i = 0; i < 8; ++i) acc[q][i] = 0.f; }
#define POOL_LOAD(W_) do { _Pragma("unroll") for (int i_ = 0; i_ < (W_) + 3; ++i_) { const int s_ = tb + 3 - i_; \
          bf16x8 v_ = {}; if (s_ >= 0) v_ = ld8(up + (size_t)s_ * NINP); \
          _Pragma("unroll") for (int q = 0; q < 4; ++q) { if (i_ >= 3 - q && i_ < 3 - q + (W_)) { _Pragma("unroll") for (int e_ = 0; e_ < 8; ++e_) acc[q][e_] += bf2f((unsigned short)v_[e_]); } \
              if (i_ == 3 - q) own[q] = v_; } } } while (0)
      if (gi == 0) POOL_LOAD(2); else if (gi == 1) POOL_LOAD(4); else if (gi == 2) POOL_LOAD(8); else POOL_LOAD(16);
#undef POOL_LOAD
#pragma unroll
      for (int q = 0; q < 4; ++q) { const int t = tb + q, lo = max(t + 1 - w, 0);
          const float inv = 1.f / (float)(t + 1 - lo); f32x4 d0, d1;
#pragma unroll
          for (int i = 0; i < 4; ++i) { d0[i] = acc[q][i] * inv - bf2f((unsigned short)own[q][i]); d1[i] = acc[q][4 + i] * inv - bf2f((unsigned short)own[q][4 + i]); }
          *reinterpret_cast<LAS bf16x8*>(dA + (tr * 4 + q) * 264 + c8 * 8) = pack8(d0, d1); } }
    __syncthreads();
    f32x4 acc[4][2];
#pragma unroll
    for (int m = 0; m < 4; ++m)
#pragma unroll
        for (int n = 0; n < 2; ++n) acc[m][n] = (f32x4){0.f, 0.f, 0.f, 0.f};
    const bf16* bp = pwt + (size_t)gi * 65536 + (size_t)(wid * 32 + fr) * 256 + fq * 8;
#pragma unroll
    for (int ks = 0; ks < 8; ++ks) {
        const bf16x8 B0 = ld8(bp + ks * 32), B1 = ld8(bp + 16 * 256 + ks * 32);
#pragma unroll
        for (int m = 0; m < 4; ++m) { const bf16x8 A = *reinterpret_cast<const LAS bf16x8*>(dA + (m * 16 + fr) * 264 + ks * 32 + fq * 8);
            acc[m][0] = __builtin_amdgcn_mfma_f32_16x16x32_bf16(A, B0, acc[m][0], 0, 0, 0);
            acc[m][1] = __builtin_amdgcn_mfma_f32_16x16x32_bf16(A, B1, acc[m][1], 0, 0, 0); }
    }
#pragma unroll
    for (int n = 0; n < 2; ++n) { const int e = wid * 32 + n * 16 + fr; const float sc = pscale[gi * 256 + e];
#pragma unroll
        for (int m = 0; m < 4; ++m)
#pragma unroll
            for (int j = 0; j < 4; ++j) mix[(size_t)(tt * 64 + m * 16 + fq * 4 + j) * DM + 3072 + gi * 256 + e] = (bf16)(cvtpk(acc[m][n][j] * sc, 0.f) & 0xffffu); }
    __syncthreads();
}

__device__ __forceinline__ void d1_scores(f32x16& p0, f32x16& p1, const bf16x8 (&kf0)[8], const bf16x8 (&kf1)[8], const LAS char* qh, int r32, int hi, int dq, const LAS float* brow, bool far) {
    bf16x8 q[2]; const LAS char* qb[4];
#pragma unroll
    for (int dd = 0; dd < 4; ++dd) qb[dd] = qh + KSWZ(r32, (dd * 16 + hi * 8) * 2);
    p0 = f32x16{}; p1 = f32x16{};
#pragma unroll
    for (int hh = 0; hh < 4; ++hh) {
#pragma unroll
        for (int dd = 0; dd < 2; ++dd) q[dd] = *reinterpret_cast<const LAS bf16x8*>(qb[(hh & 1) * 2 + dd] + (hh >> 1) * 128);
#pragma unroll
        for (int dd = 0; dd < 2; ++dd) { const int d0 = (hh >> 1) * 4 + (hh & 1) * 2 + dd; p0 = __builtin_amdgcn_mfma_f32_32x32x16_bf16(kf0[d0], q[dd], p0, 0, 0, 0); p1 = __builtin_amdgcn_mfma_f32_32x32x16_bf16(kf1[d0], q[dd], p1, 0, 0, 0); }
        SBAR();
    }
    score_tile<0>(p0, p1, dq, brow, brow[127], far, true);
}
__device__ __forceinline__ void d1_unit(int u, const bf16* proj_in, const bf16* cK_in, unsigned* selo_in, LAS unsigned char* lds, const LAS float* biasL,
                                        int tid_in, int wid, int lane_in) {
    const bf16* proj = proj_in; const bf16* cK = cK_in; unsigned* selo = selo_in; asm volatile("" : "+s"(proj), "+s"(cK), "+s"(selo));
    int tid = tid_in; asm volatile("" : "+v"(tid)); const int lane = tid & 63; (void)lane_in;
    const int tt = 255 - (u >> 2), g = u & 3, t0 = tt * 32, r32 = lane & 31, hi = lane >> 5, tpos = t0 + r32;
    const int nkt = tt / 32 + 1, kb = wid * 64;
    LAS float* scw = (LAS float*)lds + wid * 128;
    LAS float* ex = (LAS float*)(lds + 4096);
    LAS float* imp = (LAS float*)(lds + 16384);
    LAS char* Qs = (LAS char*)lds + 81920;
    const bool act = wid < nkt;
    { const int tk = tid >> 4, ch = tid & 15; const bf16* qp = proj + (size_t)(t0 + tk) * NINP + C_Q + (g * 6) * 128 + ch * 8;
      bf16x8 qv[6];
#pragma unroll
      for (int h = 0; h < 6; ++h) qv[h] = ld8(qp + h * 128);
#pragma unroll
      for (int h = 0; h < 6; ++h) *reinterpret_cast<LAS bf16x8*>(Qs + h * 8192 + KSWZ(tk, ch * 16)) = qv[h]; }
    asm volatile("s_waitcnt vmcnt(0) lgkmcnt(0)" ::: "memory"); SBAR();
    bf16x8 kf0[8], kf1[8];
    { const bf16* kp = cK + ((size_t)g * 512 + (act ? kb : 0) + r32) * 128 + hi * 8;
#pragma unroll
      for (int d0 = 0; d0 < 8; ++d0) { kf0[d0] = ld8(kp + d0 * 16); kf1[d0] = ld8(kp + 32 * 128 + d0 * 16); } }
    const int dq = tpos - 31 - 16 * kb - 64 * hi;
    const bool far = (t0 - 31 - 16 * (kb + 63)) >= 127;
    __syncthreads();
    unsigned ep[6][16];
#pragma unroll
    for (int h = 0; h < 6; ++h) {
#pragma unroll
        for (int r = 0; r < 16; ++r) ep[h][r] = 0u; }
    if (act) {
#pragma unroll
        for (int h = 0; h < 6; ++h) {
            f32x16 p0, p1; d1_scores(p0, p1, kf0, kf1, Qs + h * 8192, r32, hi, dq, biasL + (g * 6 + h) * 128, far);
            float mx = p0[0];
#pragma unroll
            for (int r = 1; r < 16; ++r) mx = fmaxf(mx, p0[r]);
#pragma unroll
            for (int r = 0; r < 16; ++r) mx = fmaxf(mx, p1[r]);
            mx = fmaxf(half_max(mx), -1e30f);
            float sm = 0.f;
#pragma unroll
            for (int r = 0; r < 16; ++r) { const float e0 = __builtin_amdgcn_exp2f(p0[r] - mx), e1 = __builtin_amdgcn_exp2f(p1[r] - mx); sm += e0 + e1; ep[h][r] = cvtpk(e0, e1); }
            sm = half_sum(sm);
            if (hi == 0) { ex[((wid * 6 + h) * 32 + r32) * 2] = mx; ex[((wid * 6 + h) * 32 + r32) * 2 + 1] = sm; }
        }
    }
    __syncthreads();
    f32x16 ia0 = {}, ia1 = {};
    if (act) {
#pragma unroll
        for (int h = 0; h < 6; ++h) {
            float M = -1e30f;
            for (int w = 0; w < nkt; ++w) M = fmaxf(M, ex[((w * 6 + h) * 32 + r32) * 2]);
            float L = 0.f;
            for (int w = 0; w < nkt; ++w) L += ex[((w * 6 + h) * 32 + r32) * 2 + 1] * __builtin_amdgcn_exp2f(ex[((w * 6 + h) * 32 + r32) * 2] - M);
            const float c = L > 0.f ? __builtin_amdgcn_exp2f(ex[((wid * 6 + h) * 32 + r32) * 2] - M) / L : 0.f;
#pragma unroll
            for (int r = 0; r < 16; ++r) { ia0[r] += __uint_as_float(ep[h][r] << 16) * c; ia1[r] += __uint_as_float(ep[h][r] & 0xffff0000u) * c; }
        }
    }
#pragma unroll
    for (int r = 0; r < 16; ++r) { imp[r32 * 512 + ((kb + crow(r, hi)) ^ r32)] = ia0[r]; imp[r32 * 512 + ((kb + 32 + crow(r, hi)) ^ r32)] = ia1[r]; }
    __syncthreads();
#pragma unroll 1
    for (int q = 0; q < 4; ++q) {
        const int tk = wid * 4 + q, t = t0 + tk, cur = t >> 6; const LAS float* ir = imp + tk * 512;
        float sv[2]; bool fo[2], cd[2];
#pragma unroll
        for (int hf = 0; hf < 2; ++hf) { const int j = lane + 64 * hf;
            float s = (j > 0) ? ir[(4 * j - 1) ^ tk] : 0.f; s += 2.f * ir[(4 * j) ^ tk]; s += 2.f * ir[(4 * j + 1) ^ tk]; s += 2.f * ir[(4 * j + 2) ^ tk]; s += ir[(4 * j + 3) ^ tk];
            const bool forced = (j == 0) || (cur - j >= 0 && cur - j < 2), future = j * 64 > t;
            sv[hf] = s; fo[hf] = forced; cd[hf] = !forced && !future; }
        const int nforced = __popcll(__ballot(fo[0])) + __popcll(__ballot(fo[1]));
        const int ncand = __popcll(__ballot(cd[0])) + __popcll(__ballot(cd[1]));
        int want = 16 - nforced; bool selA = cd[0], selB = cd[1];
        if (ncand > want) {
            const unsigned kA = __float_as_uint(sv[0]), kB = __float_as_uint(sv[1]); bool aA = cd[0], aB = cd[1]; unsigned T = 0u;
#pragma unroll 1
            for (int bit = 30; bit >= 0; --bit) { const unsigned m = 1u << bit; const bool hA = aA && (kA & m), hB = aB && (kB & m);
                const int c = __popcll(__ballot(hA)) + __popcll(__ballot(hB));
                if (c >= want) { aA = hA; aB = hB; T |= m; } else { want -= c; aA = aA && !(kA & m); aB = aB && !(kB & m); } }
            selA = cd[0] && kA >= T; selB = cd[1] && kB >= T;
        }
        const int ra = (fo[0] || selA) ? 0 : 99, rb = (fo[1] || selB) ? 0 : 99;
        const unsigned long long mA = __ballot(ra < 16), mB = __ballot(rb < 16);
        if (lane == 0) { u32x4 w = {(unsigned)mA, (unsigned)(mA >> 32), (unsigned)mB, (unsigned)(mB >> 32)}; *(u32x4*)(selo + ((size_t)g * S + t) * 4) = w; }
        LDS_WAIT();
    }
    __syncthreads();
}

__device__ __forceinline__ void d2_unit(int u, const bf16* __restrict__ proj, const unsigned char* ws, bf16* __restrict__ mix, float* __restrict__ scr, LAS unsigned char* lds,
                                        const LAS float* biasL, LAS float* al_all, int tid_in, int wid, int lane_in) {
    int tid = tid_in; asm volatile("" : "+v"(tid)); const int lane = tid & 63; (void)lane_in;
    const int ti = 63 - u / 12, hp = u % 12, g = hp / 3, head = hp * 2 + (wid >> 2);
    const int r32 = lane & 31, hi = lane >> 5, tq0 = ti * 128 + (wid & 3) * 32, tpos = tq0 + r32;
    const LAS float* brow = biasL + head * 128; const float b31 = brow[127];
    LAS float* al_l = al_all + wid * 64;
    bf16x8 qr[8];
    { const bf16* qp = proj + (size_t)tpos * NINP + C_Q + head * 128 + hi * 8;
#pragma unroll
      for (int d0 = 0; d0 < 8; ++d0) qr[d0] = ld8(qp + d0 * 16); }
    const bf16* gl = proj + (size_t)tpos * NINP + C_GL + head * 3;
    const u32x4 sel0 = {0u, 0u, 0u, 0u};
    float m_reg, l_reg; f32x16 o[4];
    { const int n_max = (ti * 128 + 96) >> 4, NT = (n_max >> 6) + 1;
      attn_branch<0>((const bf16*)(ws + WS_CK) + (size_t)g * 65536, (const bf16*)(ws + WS_CV) + (size_t)g * 65536, 128, 0, NT, lds, qr, tq0, tpos, brow, b31, sel0, m_reg, l_reg, o, al_l, tid, lane);
      const float g_cmp = sigmoidf_(bf2f(gl[0])); const float f = l_reg > 0.f ? g_cmp / l_reg : 0.f; if (hi == 0) al_l[r32] = f; LDS_WAIT();
      float* s_ = scr + lane; asm volatile("" : "+v"(s_));
#pragma unroll
      for (int r = 0; r < 16; ++r) { const float a = al_l[crow(r, hi)];
#pragma unroll
          for (int d = 0; d < 4; ++d) s_[(d * 16 + r) * 64] = o[d][r] * a; }
      LDS_WAIT(); }
    { const u32x4 selw = *(const u32x4*)((const unsigned*)(ws + WS_SEL) + ((size_t)g * S + tpos) * 4);
      attn_branch<1>(proj + C_KS + g * 128, proj + C_VS + g * 128, NINP, 0, 2 * ti + 2, lds, qr, tq0, tpos, brow, b31, selw, m_reg, l_reg, o, al_l, tid, lane);
      const float g_slc = sigmoidf_(bf2f(gl[1])); const float f = l_reg > 0.f ? g_slc / l_reg : 0.f; if (hi == 0) al_l[r32] = f; LDS_WAIT();
      float* s_ = scr + 4096 + lane; asm volatile("" : "+v"(s_));
#pragma unroll
      for (int r = 0; r < 16; ++r) { const float a = al_l[crow(r, hi)];
#pragma unroll
          for (int d = 0; d < 4; ++d) s_[(d * 16 + r) * 64] = o[d][r] * a; }
      LDS_WAIT(); }
    { const int jl = max(0, 2 * ti - 8);
      attn_branch<2>(proj + C_KW + g * 128, proj + C_VW + g * 128, NINP, jl, 2 * ti + 2, lds, qr, tq0, tpos, brow, b31, sel0, m_reg, l_reg, o, al_l, tid, lane);
      const float g_win = sigmoidf_(bf2f(gl[2])); const float f = l_reg > 0.f ? g_win / l_reg : 0.f; if (hi == 0) al_l[r32] = f; LDS_WAIT();
      const float* s_ = scr + lane; asm volatile("" : "+v"(s_));
#pragma unroll
      for (int r = 0; r < 16; ++r) { const float a = al_l[crow(r, hi)]; const int orow = tq0 + crow(r, hi);
#pragma unroll
          for (int d = 0; d < 4; ++d) { const float v = o[d][r] * a + s_[(d * 16 + r) * 64] + s_[4096 + (d * 16 + r) * 64];
              const float vn = __shfl_xor(v, 1);
              if ((r32 & 1) == 0) *(unsigned*)(mix + (size_t)orow * DM + head * 128 + d * 32 + r32) = cvtpk(v, vn); } }
      LDS_WAIT(); }
}

__device__ __forceinline__ void conv_item(int it, const bf16* __restrict__ U, const float* __restrict__ cw, const float* __restrict__ cb, bf16* __restrict__ act, int lane) {
    const int cbk = it % 22, ch = it / 22, cv = cbk * 64 + lane; if (cv >= DFF / 8) return;
    const int n = cv * 8, t0 = ch * 32;
    float wa[3][8], wb[3][8], ba[8], bb[8];
#pragma unroll
    for (int k = 0; k < 3; ++k) { const f32x4 a0 = *(const f32x4*)(cw + (size_t)k * DFF2 + n), a1 = *(const f32x4*)(cw + (size_t)k * DFF2 + n + 4), b0 = *(const f32x4*)(cw + (size_t)k * DFF2 + DFF + n), b1 = *(const f32x4*)(cw + (size_t)k * DFF2 + DFF + n + 4);
#pragma unroll
        for (int i = 0; i < 4; ++i) { wa[k][i] = a0[i]; wa[k][4 + i] = a1[i]; wb[k][i] = b0[i]; wb[k][4 + i] = b1[i]; } }
    { const f32x4 a0 = *(const f32x4*)(cb + n), a1 = *(const f32x4*)(cb + n + 4), b0 = *(const f32x4*)(cb + DFF + n), b1 = *(const f32x4*)(cb + DFF + n + 4);
#pragma unroll
      for (int i = 0; i < 4; ++i) { ba[i] = a0[i]; ba[4 + i] = a1[i]; bb[i] = b0[i]; bb[4 + i] = b1[i]; } }
    float a2[8], a1_[8], b2[8], b1_[8];
#pragma unroll
    for (int i = 0; i < 8; ++i) { a2[i] = 0.f; a1_[i] = 0.f; b2[i] = 0.f; b1_[i] = 0.f; }
    if (t0 > 0) { const bf16x8 xa2 = ld8(U + (size_t)(t0 - 2) * DFF2 + n), xa1 = ld8(U + (size_t)(t0 - 1) * DFF2 + n), xb2 = ld8(U + (size_t)(t0 - 2) * DFF2 + DFF + n), xb1 = ld8(U + (size_t)(t0 - 1) * DFF2 + DFF + n);
#pragma unroll
        for (int i = 0; i < 8; ++i) { a2[i] = bf2f((unsigned short)xa2[i]); a1_[i] = bf2f((unsigned short)xa1[i]); b2[i] = bf2f((unsigned short)xb2[i]); b1_[i] = bf2f((unsigned short)xb1[i]); } }
#pragma unroll 8
    for (int t = t0; t < t0 + 32; ++t) {
        const bf16x8 xa = ld8(U + (size_t)t * DFF2 + n), xb = ld8(U + (size_t)t * DFF2 + DFF + n);
        float r[8];
#pragma unroll
        for (int i = 0; i < 8; ++i) { const float ua = bf2f((unsigned short)xa[i]), ub = bf2f((unsigned short)xb[i]);
            const float a = ba[i] + wa[0][i] * a2[i] + wa[1][i] * a1_[i] + wa[2][i] * ua;
            const float b = bb[i] + wb[0][i] * b2[i] + wb[1][i] * b1_[i] + wb[2][i] * ub;
            r[i] = a * sigmoidf_(a) * b; a2[i] = a1_[i]; a1_[i] = ua; b2[i] = b1_[i]; b1_[i] = ub; }
        u32x4 w = {cvtpk(r[0], r[1]), cvtpk(r[2], r[3]), cvtpk(r[4], r[5]), cvtpk(r[6], r[7])};
        *(u32x4*)(act + (size_t)t * DFF + n) = w;
    }
}


__device__ __forceinline__ void conv_fix_item(int it, const bf16* __restrict__ halo, const float* __restrict__ cw, const float* __restrict__ cb, bf16* __restrict__ act, int lane) {
    const int cbk = it % 22, pr = it / 22, panel = pr >> 1, r = pr & 1, cv = cbk * 64 + lane; if (cv >= DFF / 8) return;
    const int n = cv * 8, t = panel * 64 + r;
    const bf16* h0 = halo + ((size_t)panel * 4 + r) * DFF2 + n;
    const bf16* h1 = r ? halo + ((size_t)panel * 4 + 0) * DFF2 + n : halo + ((size_t)(panel - 1) * 4 + 3) * DFF2 + n;
    const bf16* h2 = r ? halo + ((size_t)(panel - 1) * 4 + 3) * DFF2 + n : halo + ((size_t)(panel - 1) * 4 + 2) * DFF2 + n;
    const bool v1 = r || panel > 0, v2 = panel > 0;
    bf16x8 z = {}; const bf16x8 ua = ld8(h0), ub = ld8(h0 + DFF), ua1 = v1 ? ld8(h1) : z, ub1 = v1 ? ld8(h1 + DFF) : z, ua2 = v2 ? ld8(h2) : z, ub2 = v2 ? ld8(h2 + DFF) : z;
    float o[8];
#pragma unroll
    for (int i = 0; i < 8; ++i) {
        const float a = cb[n + i] + cw[n + i] * bf2f((unsigned short)ua2[i]) + cw[DFF2 + n + i] * bf2f((unsigned short)ua1[i]) + cw[2 * DFF2 + n + i] * bf2f((unsigned short)ua[i]);
        const float b = cb[DFF + n + i] + cw[DFF + n + i] * bf2f((unsigned short)ub2[i]) + cw[DFF2 + DFF + n + i] * bf2f((unsigned short)ub1[i]) + cw[2 * DFF2 + DFF + n + i] * bf2f((unsigned short)ub[i]);
        o[i] = a * sigmoidf_(a) * b; }
    u32x4 w = {cvtpk(o[0], o[1]), cvtpk(o[2], o[3]), cvtpk(o[4], o[5]), cvtpk(o[6], o[7])};
    *(u32x4*)(act + (size_t)t * DFF + n) = w;
}
#define XB_TMO      128
#define XB_XCNT(j)  (256  + 64 * (j))
#define XB_XSUB(j)  (1280 + 64 * (j))
#define XB_XGEN(j)  (2304 + 64 * (j))
#define XB_TOP      3328
#define XB_TOPGEN   3392
#define XCD_BAR_WORDS 3456
#define XB_SPIN_CAP (1u << 18)

__device__ __forceinline__ unsigned xb_ld(unsigned* p)              { return __hip_atomic_load(p, __ATOMIC_RELAXED, __HIP_MEMORY_SCOPE_AGENT); }
__device__ __forceinline__ unsigned xb_add(unsigned* p, unsigned v) { return __hip_atomic_fetch_add(p, v, __ATOMIC_RELAXED, __HIP_MEMORY_SCOPE_AGENT); }
__device__ __forceinline__ unsigned xb_xcc_id() { return (unsigned)__builtin_amdgcn_s_getreg((3 << 11) | 20) & 0xFu; }
#define XB_SPIN(cond, bar) do { unsigned _sp = 0; while (cond) { __builtin_amdgcn_s_sleep(1); \
    if ((++_sp & 255u) == 0u) { if (xb_ld(&(bar)[XB_TMO])) break; if (_sp > XB_SPIN_CAP) { atomicAdd(&(bar)[XB_TMO], 1u); break; } } } } while (0)

struct XcdBarrier {
    unsigned* bar; unsigned x;
    volatile LAS unsigned* st;
};

__device__ __forceinline__ XcdBarrier xcd_barrier_post(unsigned* bar, volatile LAS unsigned* st) {
    XcdBarrier b; b.bar = bar; b.x = xb_xcc_id(); b.st = st;
    if (threadIdx.x == 0) (void)xb_add(&bar[XB_XCNT(b.x)], 1u);
    return b;
}
__device__ __forceinline__ void xcd_barrier_complete(unsigned* bar, unsigned x, unsigned& nloc, unsigned& nx) {
    const unsigned G = gridDim.x * gridDim.y * gridDim.z;
    unsigned sum, cnt, mine, sp = 0u;
    for (;;) {
        sum = 0u; cnt = 0u; mine = 0u;
#pragma unroll
        for (unsigned j = 0; j < 16; ++j) { const unsigned c = xb_ld(&bar[XB_XCNT(j)]); sum += c; cnt += (c > 0u) ? 1u : 0u; mine = (j == x) ? c : mine; }
        if (sum == G) break;
        __builtin_amdgcn_s_sleep(1);
        if ((++sp & 255u) == 0u) { if (xb_ld(&bar[XB_TMO])) break; if (sp > XB_SPIN_CAP) { atomicAdd(&bar[XB_TMO], 1u); break; } }
    }
    nloc = mine > 0u ? mine : 1u; nx = cnt > 0u ? cnt : 1u;
}

__device__ __forceinline__ void xcd_barrier(const XcdBarrier& b) {
    asm volatile("s_waitcnt vmcnt(0)" ::: "memory");
    __syncthreads();
    if (threadIdx.x == 0) {
        unsigned* bar = b.bar;
        __builtin_amdgcn_s_waitcnt(0);
        unsigned nloc = b.st[0], nx = b.st[1];
        if (nloc == 0u) { xcd_barrier_complete(bar, b.x, nloc, nx); b.st[0] = nloc; b.st[1] = nx; }
        const unsigned old = xb_add(&bar[XB_XSUB(b.x)], 1u);
        const unsigned gen = old / nloc;
        if (old + 1u == (gen + 1u) * nloc) {
            __builtin_amdgcn_fence(__ATOMIC_RELEASE, "agent");
            asm volatile("s_waitcnt vmcnt(0)" ::: "memory");
            const unsigned og = xb_add(&bar[XB_TOP], 1u);
            const unsigned tg = og / nx;
            if (og + 1u == (tg + 1u) * nx) xb_add(&bar[XB_TOPGEN], 1u);
            else XB_SPIN(xb_ld(&bar[XB_TOPGEN]) == tg, bar);
            __builtin_amdgcn_fence(__ATOMIC_ACQUIRE, "agent");
            xb_add(&bar[XB_XGEN(b.x)], 1u);
            asm volatile("s_waitcnt vmcnt(0)" ::: "memory");
        } else {
            XB_SPIN(xb_ld(&bar[XB_XGEN(b.x)]) == gen, bar);
            __builtin_amdgcn_fence(__ATOMIC_ACQUIRE, "agent");
            asm volatile("s_waitcnt vmcnt(0)" ::: "memory");
        }
    }
    __syncthreads();
}

constexpr int NPH = 11;
__global__ void __launch_bounds__(512) mk_fwd(Params P) {
    extern __shared__ __attribute__((aligned(16))) unsigned char lds_raw[];
    cg::grid_group grid = cg::this_grid();
    LAS unsigned char* lds = (LAS unsigned char*)lds_raw;
    const int tid = threadIdx.x, lane = tid & 63, wid = __builtin_amdgcn_readfirstlane(tid >> 6);
    const int G = gridDim.x, gw = blockIdx.x * 8 + wid, NGW = G * 8;
    unsigned char* ws = P.ws;
    LAS float* biasL = (LAS float*)(lds + LDS_BIAS); LAS float* al_all = (LAS float*)(lds + LDS_AL); volatile LAS unsigned* misc = (volatile LAS unsigned*)(lds + LDS_MISC);
    const int lo = P.ph_lo, hi_ph = P.ph_hi;
#ifndef ONLY_PH
#define ONLY_PH -1
#endif
#define IN(k) ((ONLY_PH < 0 || ONLY_PH == (k)) && lo <= (k) && (k) < hi_ph)
#define SEAM(k) do { if (IN(k) && IN((k) + 1)) xcd_barrier(xbar); } while (0)
    for (int i = tid; i < 24 * 128; i += 512) { const int h = i >> 7, d = i & 127; int b;
        if (d < 16) b = d; else { b = 16; b += d >= 19; b += d >= 21; b += d >= 24; b += d >= 27; b += d >= 31; b += d >= 35; b += d >= 40; b += d >= 46; b += d >= 52; b += d >= 59; b += d >= 67; b += d >= 77; b += d >= 87; b += d >= 99; b += d >= 113; }
        biasL[i] = P.in[11][b * 24 + h] * LOG2E; }
    __syncthreads();
    if (tid == 0) { misc[8] = 0u; misc[9] = 0u; }
    __syncthreads();
    const XcdBarrier xbar = xcd_barrier_post((unsigned*)(ws + WS_CTL) + 1024, misc + 8);
    if (P.ph_hi > 1000) grid.sync();
    bf16* HN = (bf16*)(ws + WS_HN); bf16* PROJ = (bf16*)(ws + WS_PROJ); bf16* MIX = (bf16*)(ws + WS_MIX); float* H1 = (float*)(ws + WS_H1);
    bf16* UB = (bf16*)(ws + WS_U); bf16* ACT = (bf16*)(ws + WS_ACT);

    if (IN(0)) {
        int tid_ = threadIdx.x; asm volatile("" : "+v"(tid_)); const int tid = tid_, lane = tid_ & 63;
        LAS float* scr = (LAS float*)(lds + wid * 16384);
        constexpr int I0 = 64 * 227, I1 = 0, I2 = 0, I3 = 0,     I4 = 4 * 8, I5 = 64 * 4, I6 = 2 * 4;
        constexpr int NIT = I0 + I1 + I2 + I3 + 4 * I4 + 2 * I5 + 2 * I6;
        for (int it = gw; it < NIT; it += NGW) {
            int r = it;
            if (r < I0) { tr_item(P.in[2], 4096, NIN, (bf16*)(ws + WS_WIN_T), scr, r, lane); continue; } r -= I0;
            if (r < I1) { tr_item(P.in[12], 4096, 4096, (bf16*)(ws + WS_WOUT_T), scr, r, lane); continue; } r -= I1;
            if (r < I2) { tr_item<true>(P.in[14], 4096, DFF2, (bf16*)(ws + WS_WUP_T), scr, r, lane, P.in[13]); continue; } r -= I2;
            if (r < I3) { tr_item(P.in[17], DFF, 4096, (bf16*)(ws + WS_WDN_T), scr, r + 19200, lane); continue; } r -= I3;
            if (r < 4 * I4) { const int gi = r / I4; tr_item(P.in[3] + (size_t)gi * 65536, 256, 256, (bf16*)(ws + WS_PWT) + (size_t)gi * 65536, scr, r - gi * I4, lane); continue; } r -= 4 * I4;
            if (r < I5) { tr_item(P.in[6], 4096, 128, (bf16*)(ws + WS_W1KT), scr, r, lane); continue; } r -= I5;
            if (r < I5) { tr_item(P.in[9], 4096, 128, (bf16*)(ws + WS_W1VT), scr, r, lane); continue; } r -= I5;
            if (r < I6) { tr_item(P.in[7], 128, 128, (bf16*)(ws + WS_W2KT), scr, r, lane); continue; } r -= I6;
            tr_item(P.in[10], 128, 128, (bf16*)(ws + WS_W2VT), scr, r, lane);
        }
        { u32x4* z = (u32x4*)((bf16*)(ws + WS_WIN_T) + (size_t)NIN * 4096); const size_t nz = (size_t)(NINP - NIN) * 4096 * 2 / 16;
          for (size_t i = (size_t)blockIdx.x * 512 + tid; i < nz; i += (size_t)G * 512) z[i] = (u32x4){0u, 0u, 0u, 0u}; }
        for (int m = gw; m < S; m += NGW) rms_row_bf16(P.in[0] + (size_t)m * DM, P.in[1], HN + (size_t)m * DM, lane);
        __syncthreads();
    }
    SEAM(0);
    if (IN(1)) {
        pg8::Gemm g{HN, (const bf16*)(ws + WS_WIN_T), S, NINP, DM}; pg8::StaticOrder So; So.init(S, NINP, G, (int)blockIdx.x);
        pg8::EpiBf16<0> E{PROJ, NINP, nullptr, 0, 0};
        pg8::gemm_phase<pg8::EpiBf16<0>, pg8::StaticOrder, true, true>(lds, g, So, E);
        if (G == 256 && blockIdx.x >= 160) {
            LAS float* scr = (LAS float*)(lds + wid * 16384);
            for (int it = ((int)blockIdx.x - 160) * 8 + wid; it < 11008; it += 96 * 8) tr_item<false, true>(P.in[17], DFF, 4096, (bf16*)(ws + WS_WDN_T), scr, it, lane);
            __syncthreads(); }
        else if (G != 256) { LAS float* scr = (LAS float*)(lds + wid * 16384); for (int it = gw; it < 11008; it += NGW) tr_item(P.in[17], DFF, 4096, (bf16*)(ws + WS_WDN_T), scr, it, lane); __syncthreads(); }
    }
    SEAM(1);
    if (IN(2)) {
        for (int u = blockIdx.x; u < 256; u += G) compress_v3(u, PROJ, P.in[5], P.in[8], ws, lds, tid, wid, lane);
    }
    SEAM(2);
    if (IN(3)) {
        int tid_ = threadIdx.x; asm volatile("" : "+v"(tid_)); const int tid = tid_, lane = tid_ & 63;
        for (int u = blockIdx.x; u < 1024; u += G) d1_unit(u, PROJ, (const bf16*)(ws + WS_CK), (unsigned*)(ws + WS_SEL), lds, biasL, tid, wid, lane);
    }
    SEAM(3);
    if (IN(4)) {
        int tid_ = threadIdx.x; asm volatile("" : "+v"(tid_)); const int tid = tid_, lane = tid_ & 63;
        unsigned* ctr = (unsigned*)(ws + WS_CTL);
        float* scr = (float*)(ws + WS_SCR) + (size_t)gw * 8192;
        for (;;) {
            __syncthreads();
            if (tid == 0) misc[0] = atomicAdd(ctr, 1u);
            __syncthreads();
            const int u = (int)misc[0];
            if (u >= 2150) break;
            int v; bool conv;
            { const int g5 = u / 5, r5 = u - g5 * 5;
              conv = (r5 == 1) || (r5 == 3); v = conv ? 2 * g5 + (r5 == 3) : 3 * g5 + (r5 == 0 ? 0 : (r5 == 2 ? 1 : 2)); }
            if (!conv && v >= 768 + 512) continue;
            if (conv) {
                LAS float* tscr = (LAS float*)(lds + wid * 16384);
#pragma unroll 1
                for (int j = 0; j < 8; ++j) { int r = v * 64 + j * 8 + wid;
                    if (r < 44032) { tr_item<true, true>(P.in[14], 4096, DFF2, (bf16*)(ws + WS_WUP_T), tscr, r, lane, P.in[13]); continue; } r -= 44032;
                    if (r < 8192) { tr_item<false, true>(P.in[12], 4096, 4096, (bf16*)(ws + WS_WOUT_T), tscr, r, lane); continue; } r -= 8192;
                    tr_item<false, true>(P.in[17], DFF, 4096, (bf16*)(ws + WS_WDN_T), tscr, r + 19200, lane); }
                continue; }
            if (v >= 768) { pool_unit(v - 768, PROJ, (const bf16*)(ws + WS_PWT), P.in[4], MIX, lds, tid, wid, lane); continue; }
            d2_unit(v, PROJ, ws, MIX, scr, lds, biasL, al_all, tid, wid, lane);
        }
    }
    SEAM(4);
    if (IN(5)) {
        pg8::Gemm g{MIX, (const bf16*)(ws + WS_WOUT_T), S, DM, DM}; pg8::StaticOrder So; So.init(S, DM, G, (int)blockIdx.x);
        pg8::EpiF32ResNorm E{H1, DM, P.in[0], HN, (float*)(ws + WS_CTL + 32768)};
        pg8::gemm_phase<pg8::EpiF32ResNorm, pg8::StaticOrder, true, true>(lds, g, So, E);
    }
    SEAM(5);
    SEAM(6);
    if (IN(7)) {
        pg8::Gemm g{HN, (const bf16*)(ws + WS_WUP_T), S, DFF2, DM}; pg8::StaticOrder So; So.init(S, DFF2, G, (int)blockIdx.x);
        pg8::EpiConv E{ACT, UB, P.in[15], P.in[16], DFF, (const float*)(ws + WS_CTL + 32768)};
        pg8::gemm_phase<pg8::EpiConv, pg8::StaticOrder, true, true>(lds, g, So, E);
        if (G == 256 && blockIdx.x >= 192) {
            LAS float* scr = (LAS float*)(lds + wid * 16384);
            for (int it = 11008 + ((int)blockIdx.x - 192) * 8 + wid; it < 19200; it += 64 * 8) tr_item<false, true>(P.in[17], DFF, 4096, (bf16*)(ws + WS_WDN_T), scr, it, lane);
            __syncthreads(); }
        else if (G != 256) { LAS float* scr = (LAS float*)(lds + wid * 16384); for (int it = 11008 + gw; it < 19200; it += NGW) tr_item(P.in[17], DFF, 4096, (bf16*)(ws + WS_WDN_T), scr, it, lane); __syncthreads(); }
    }
    SEAM(7);
    if (IN(8)) { for (int it = gw; it < 256 * 22; it += NGW) conv_fix_item(it, UB, P.in[15], P.in[16], ACT, lane); }
    SEAM(8);
    if (IN(9)) {
        pg8::Gemm g{ACT, (const bf16*)(ws + WS_WDN_T), S, DM, DFF}; pg8::StaticOrder So; So.init(S, DM, G, (int)blockIdx.x);
        pg8::EpiBf16ResB E{(bf16*)H1, DM, HN};
        pg8::gemm_phase<pg8::EpiBf16ResB, pg8::StaticOrder, true, true>(lds, g, So, E);
    }
    SEAM(9);
    if (IN(10)) { for (int m = gw; m < S; m += NGW) rms_row_b2f((const bf16*)H1 + (size_t)m * DM, P.in[18], P.out + (size_t)m * DM, lane); }
#undef IN
#undef SEAM
}

#ifndef MK_MULTI
#define MK_MULTI 0
#endif
extern "C" void kernel_launch(void* const* d_in, const int* in_sizes, int n_in, void* d_out, int out_size, void* d_ws, size_t ws_size, hipStream_t stream) {
    static int grid = 0;
    if (grid == 0) {
        if (n_in != 19 || out_size != S * DM || ws_size < WS_END) { fprintf(stderr, "kernel_launch: unexpected shapes (n_in %d out %d ws %zu)\n", n_in, out_size, ws_size); grid = -1; return; }
        int dev = 0, cus = 0, per_cu = 0;
        (void)hipGetDevice(&dev); (void)hipDeviceGetAttribute(&cus, hipDeviceAttributeMultiprocessorCount, dev);
        if (hipFuncSetAttribute((const void*)mk_fwd, hipFuncAttributeMaxDynamicSharedMemorySize, LDS_BYTES) != hipSuccess) { fprintf(stderr, "kernel_launch: hipFuncSetAttribute failed\n"); grid = -1; return; }
        if (hipOccupancyMaxActiveBlocksPerMultiprocessor(&per_cu, (const void*)mk_fwd, 512, LDS_BYTES) != hipSuccess || per_cu < 1) { fprintf(stderr, "kernel_launch: occupancy query says %d\n", per_cu); per_cu = 1; }
        (void)hipGetLastError();
        grid = cus * 1;
        if (grid <= 0) grid = 256;
    }
    if (grid < 0) return;
    (void)hipMemsetAsync((char*)d_ws + WS_CTL, 0, CTL_BYTES, stream);
    Params p{};
    for (int i = 0; i < 19; ++i) p.in[i] = (const float*)d_in[i];
    p.out = (float*)d_out; p.ws = (unsigned char*)d_ws;
#if MK_MULTI
    for (int ph = 0; ph < NPH; ++ph) { p.ph_lo = ph; p.ph_hi = ph + 1; hipLaunchKernelGGL(mk_fwd, dim3(grid), dim3(512), LDS_BYTES, stream, p); }
#else
    p.ph_lo = 0; p.ph_hi = NPH;
    void* args[] = {&p};
    hipError_t e = hipLaunchCooperativeKernel((const void*)mk_fwd, dim3(grid), dim3(512), args, LDS_BYTES, stream);
    if (e != hipSuccess) fprintf(stderr, "kernel_launch: cooperative launch failed: %s (grid %d)\n", hipGetErrorString(e), grid);
#endif
}
```
